# Optimizing an MI355X kernel written in HIP

```python
import jax, jax.numpy as jnp
from jax import lax
import numpy as np

D_MODEL = 1024
BATCH = 4
SEQ = 4096
DEPTH = 4

N_MIXERS = 2
ROPE_THETA = 500000.0
RMS_EPS = 1e-6
Q_BLOCK = 128
MLA_HEADS = 16
MLA_NOPE = 128
MLA_ROPE = 64
MLA_V = 128
MLA_QK = MLA_NOPE + MLA_ROPE
MLA_Q_LORA = 384
MLA_KV_LORA = 256
MLA_IN = MLA_Q_LORA + MLA_KV_LORA + MLA_ROPE + MLA_HEADS * MLA_V
NSA_HEADS = 16
NSA_GROUPS = 4
NSA_HPG = NSA_HEADS // NSA_GROUPS
NSA_DK = 96
NSA_DV = 64
NSA_ROT = NSA_DK // 4
CMP_LEN = 32
CMP_STRIDE = 16
SEL_LEN = 64
N_SELECT = 16
WINDOW = 512
NSA_Q_BLOCK = 64
SEL_FORCE = 1e4
NSA_SIZES = (NSA_HEADS * NSA_DK,
             NSA_GROUPS * NSA_DK, NSA_GROUPS * NSA_DV,
             NSA_GROUPS * NSA_DK, NSA_GROUPS * NSA_DV,
             NSA_GROUPS * NSA_DK, NSA_GROUPS * NSA_DV,
             3 * NSA_HEADS, NSA_HEADS * NSA_DV)
NSA_IN = sum(NSA_SIZES)

kernel_name = "hybrid_mla_nsa_gated_trunk"


def rms_norm(x, g):
    xf = x.astype(jnp.float32)
    y = xf * lax.rsqrt(jnp.mean(xf * xf, axis=-1, keepdims=True) + RMS_EPS)
    return (y * g.astype(jnp.float32)).astype(x.dtype)


def rope(x, pos, rot_dim):
    half = rot_dim // 2
    inv_freq = ROPE_THETA ** (-jnp.arange(half, dtype=jnp.float32) / half)
    ang = pos.astype(jnp.float32)[:, :, None] * inv_freq
    cos = jnp.cos(ang)[:, :, None, :]
    sin = jnp.sin(ang)[:, :, None, :]
    xf = x[..., :rot_dim].astype(jnp.float32)
    x1, x2 = xf[..., :half], xf[..., half:]
    rot = jnp.concatenate([x1 * cos - x2 * sin, x2 * cos + x1 * sin], axis=-1)
    return jnp.concatenate([rot.astype(x.dtype), x[..., rot_dim:]], axis=-1)


def masked_softmax(s, mask):
    s = jnp.where(mask, s, -jnp.inf)
    m = jnp.max(s, axis=-1, keepdims=True)
    m = jnp.where(jnp.isfinite(m), m, 0.0)
    e = jnp.exp(s - m)
    d = jnp.sum(e, axis=-1, keepdims=True)
    return e / jnp.where(d > 0, d, 1.0)


def causal_block_attention(q, k, v, scale):
    S = q.shape[1]
    outs = []
    for start in range(0, S, Q_BLOCK):
        end = min(start + Q_BLOCK, S)
        s = jnp.einsum('bqhd,bkhd->bhqk', q[:, start:end], k[:, :end],
                       preferred_element_type=jnp.float32) * scale
        mask = jnp.arange(start, end)[:, None] >= jnp.arange(end)[None, :]
        p = jax.nn.softmax(jnp.where(mask, s, -jnp.inf), axis=-1)
        outs.append(jnp.einsum('bhqk,bkhd->bqhd', p.astype(v.dtype), v[:, :end]))
    return jnp.concatenate(outs, axis=1)


def mla_mixer(h, pos, w_in, g_cq, w_uq, g_ckv, w_ukv, g_q, g_k, w_out):
    B, S, _ = h.shape
    proj = h @ w_in
    c_q, c_kv, k_pe, z = jnp.split(
        proj, [MLA_Q_LORA, MLA_Q_LORA + MLA_KV_LORA, MLA_Q_LORA + MLA_KV_LORA + MLA_ROPE], axis=-1)
    q = (rms_norm(c_q, g_cq) @ w_uq).reshape(B, S, MLA_HEADS, MLA_QK)
    kv = (rms_norm(c_kv, g_ckv) @ w_ukv).reshape(B, S, MLA_HEADS, MLA_NOPE + MLA_V)
    k_nope, v = kv[..., :MLA_NOPE], kv[..., MLA_NOPE:]
    k_pe = jnp.broadcast_to(k_pe[:, :, None, :], (B, S, MLA_HEADS, MLA_ROPE))
    k = jnp.concatenate([k_pe, k_nope], axis=-1)
    q = rope(rms_norm(q, g_q), pos, MLA_ROPE)
    k = rope(rms_norm(k, g_k), pos, MLA_ROPE)
    o = causal_block_attention(q, k, v, MLA_QK ** -0.5)
    o = o.reshape(B, S, MLA_HEADS * MLA_V) * jax.nn.silu(z)
    return o @ w_out


def compress(t, tok_idx, pe, w1, w2):
    B, _, G, d = t.shape
    n, L = tok_idx.shape
    blk = t[:, tok_idx] + pe[:, None, :]
    blk = jnp.moveaxis(blk, 3, 2).reshape(B, n, G, L * d)
    return jax.nn.silu(blk @ w1) @ w2


def nsa_mixer(h, pos, w_in, g_q, g_k, pe_k, w1_k, w2_k, pe_v, w1_v, w2_v, w_out):
    B, S, _ = h.shape
    G, HPG, DK, DV = NSA_GROUPS, NSA_HPG, NSA_DK, NSA_DV
    splits = [int(c) for c in np.cumsum(NSA_SIZES)[:-1]]
    q, kc, vc, ks, vs, kw, vw, gl, z = jnp.split(h @ w_in, splits, axis=-1)
    q = rope(rms_norm(q.reshape(B, S, NSA_HEADS, DK), g_q), pos, NSA_ROT)
    ks = rope(rms_norm(ks.reshape(B, S, G, DK), g_k[1]), pos, NSA_ROT)
    kw = rope(rms_norm(kw.reshape(B, S, G, DK), g_k[2]), pos, NSA_ROT)
    vs = vs.reshape(B, S, G, DV)
    vw = vw.reshape(B, S, G, DV)
    gates = jax.nn.sigmoid(gl).reshape(B, S, NSA_HEADS, 3)
    scale = DK ** -0.5

    n_cmp = (S - CMP_LEN) // CMP_STRIDE + 1
    cmp_start = jnp.arange(n_cmp) * CMP_STRIDE
    tok_idx = cmp_start[:, None] + jnp.arange(CMP_LEN)[None, :]
    cmp_end = cmp_start + CMP_LEN - 1
    k_cmp = compress(kc.reshape(B, S, G, DK), tok_idx, pe_k, w1_k, w2_k)
    k_cmp = rope(rms_norm(k_cmp, g_k[0]), pos[:, cmp_end], NSA_ROT)
    v_cmp = compress(vc.reshape(B, S, G, DV), tok_idx, pe_v, w1_v, w2_v)

    n_sel_blk = S // SEL_LEN
    k_sel = min(N_SELECT, n_sel_blk)
    ks_blk = ks.reshape(B, n_sel_blk, SEL_LEN, G, DK).transpose(0, 3, 1, 2, 4)
    vs_blk = vs.reshape(B, n_sel_blk, SEL_LEN, G, DV).transpose(0, 3, 1, 2, 4)
    sel_start = jnp.arange(n_sel_blk) * SEL_LEN
    overlap = ((cmp_start[:, None] < sel_start[None, :] + SEL_LEN)
               & (cmp_start[:, None] + CMP_LEN > sel_start[None, :])).astype(jnp.float32)
    blk_ids = jnp.arange(n_sel_blk)
    bi = jnp.arange(B)[:, None, None, None]
    gi = jnp.arange(G)[None, :, None, None]

    kw_pad = jnp.pad(kw, ((0, 0), (WINDOW, 0), (0, 0), (0, 0)))
    vw_pad = jnp.pad(vw, ((0, 0), (WINDOW, 0), (0, 0), (0, 0)))

    Tq = NSA_Q_BLOCK
    n_chunks = S // Tq
    q_ch = jnp.moveaxis(q.reshape(B, n_chunks, Tq, G, HPG, DK), 1, 0)
    g_ch = jnp.moveaxis(gates.reshape(B, n_chunks, Tq, G, HPG, 3), 1, 0)
    starts = jnp.arange(n_chunks, dtype=jnp.int32) * Tq

    def chunk(args):
        qc, gc, start = args
        t = start + jnp.arange(Tq)
        s_c = jnp.einsum('btghd,bngd->bghtn', qc, k_cmp,
                         preferred_element_type=jnp.float32) * scale
        p_c = masked_softmax(s_c, cmp_end[None, :] <= t[:, None])
        o_c = jnp.einsum('bghtn,bngd->btghd', p_c.astype(v_cmp.dtype), v_cmp)
        imp = jnp.einsum('bgtn,nk->bgtk', p_c.sum(axis=2), overlap)
        cur = t // SEL_LEN
        valid = sel_start[None, :] <= t[:, None]
        forced = ((blk_ids[None, :] == 0) | (blk_ids[None, :] == cur[:, None])
                  | (blk_ids[None, :] == cur[:, None] - 1))
        score = jnp.where(forced, SEL_FORCE, jnp.where(valid, imp, -1.0))
        _, sel = lax.top_k(score, k_sel)
        k_g = ks_blk[bi, gi, sel].reshape(B, G, Tq, k_sel * SEL_LEN, DK)
        v_g = vs_blk[bi, gi, sel].reshape(B, G, Tq, k_sel * SEL_LEN, DV)
        key_tok = (sel[..., None] * SEL_LEN + jnp.arange(SEL_LEN)).reshape(B, G, Tq, k_sel * SEL_LEN)
        s_s = jnp.einsum('btghd,bgtkd->bghtk', qc, k_g,
                         preferred_element_type=jnp.float32) * scale
        p_s = masked_softmax(s_s, (key_tok <= t[None, None, :, None])[:, :, None])
        o_s = jnp.einsum('bghtk,bgtkd->btghd', p_s.astype(v_g.dtype), v_g)
        kb = lax.dynamic_slice_in_dim(kw_pad, start, WINDOW + Tq, axis=1)
        vb = lax.dynamic_slice_in_dim(vw_pad, start, WINDOW + Tq, axis=1)
        kt = start - WINDOW + jnp.arange(WINDOW + Tq)
        m_w = (kt[None, :] <= t[:, None]) & (kt[None, :] > t[:, None] - WINDOW) & (kt[None, :] >= 0)
        s_w = jnp.einsum('btghd,bkgd->bghtk', qc, kb,
                         preferred_element_type=jnp.float32) * scale
        p_w = masked_softmax(s_w, m_w)
        o_w = jnp.einsum('bghtk,bkgd->btghd', p_w.astype(vb.dtype), vb)
        return gc[..., 0:1] * o_c + gc[..., 1:2] * o_s + gc[..., 2:3] * o_w

    o = lax.map(chunk, (q_ch, g_ch, starts))
    o = jnp.moveaxis(o, 0, 1).reshape(B, S, NSA_HEADS * DV) * jax.nn.silu(z)
    return o @ w_out


def setup_inputs(seed: int = 0) -> dict:
    key = jax.random.key(seed)
    k = jax.random.split(key, 24)
    n_mla = (DEPTH + N_MIXERS - 1) // N_MIXERS
    n_nsa = (DEPTH + N_MIXERS - 2) // N_MIXERS

    def dense(kk, shape):
        return jax.random.normal(kk, shape, jnp.float32) * shape[-2] ** -0.5

    def gain(kk, shape):
        return 1.0 + 0.05 * jax.random.normal(kk, shape, jnp.float32)

    x = jax.random.normal(k[0], (BATCH, SEQ, D_MODEL), jnp.float32)
    offsets = jax.random.randint(k[1], (BATCH, 1), 0, 1024, dtype=jnp.int32)
    positions = offsets + jnp.arange(SEQ, dtype=jnp.int32)[None, :]
    return {
        "x": x,
        "positions": positions,
        "norm_g": gain(k[2], (DEPTH, D_MODEL)),
        "mla_w_in": dense(k[3], (n_mla, D_MODEL, MLA_IN)),
        "mla_g_cq": gain(k[4], (n_mla, MLA_Q_LORA)),
        "mla_w_uq": dense(k[5], (n_mla, MLA_Q_LORA, MLA_HEADS * MLA_QK)),
        "mla_g_ckv": gain(k[6], (n_mla, MLA_KV_LORA)),
        "mla_w_ukv": dense(k[7], (n_mla, MLA_KV_LORA, MLA_HEADS * (MLA_NOPE + MLA_V))),
        "mla_g_q": gain(k[8], (n_mla, MLA_QK)),
        "mla_g_k": gain(k[9], (n_mla, MLA_QK)),
        "mla_w_out": dense(k[10], (n_mla, MLA_HEADS * MLA_V, D_MODEL)),
        "nsa_w_in": dense(k[11], (n_nsa, D_MODEL, NSA_IN)),
        "nsa_g_q": gain(k[12], (n_nsa, NSA_DK)),
        "nsa_g_k": gain(k[13], (n_nsa, 3, NSA_DK)),
        "nsa_pe_k": 0.02 * jax.random.normal(k[14], (n_nsa, CMP_LEN, NSA_DK), jnp.float32),
        "nsa_w1_k": dense(k[15], (n_nsa, CMP_LEN * NSA_DK, NSA_DK)),
        "nsa_w2_k": dense(k[16], (n_nsa, NSA_DK, NSA_DK)),
        "nsa_pe_v": 0.02 * jax.random.normal(k[17], (n_nsa, CMP_LEN, NSA_DV), jnp.float32),
        "nsa_w1_v": dense(k[18], (n_nsa, CMP_LEN * NSA_DV, NSA_DV)),
        "nsa_w2_v": dense(k[19], (n_nsa, NSA_DV, NSA_DV)),
        "nsa_w_out": dense(k[20], (n_nsa, NSA_HEADS * NSA_DV, D_MODEL)),
    }


def reference(x, positions, norm_g, mla_w_in, mla_g_cq, mla_w_uq, mla_g_ckv, mla_w_ukv,
              mla_g_q, mla_g_k, mla_w_out, nsa_w_in, nsa_g_q, nsa_g_k, nsa_pe_k, nsa_w1_k,
              nsa_w2_k, nsa_pe_v, nsa_w1_v, nsa_w2_v, nsa_w_out):
    for i in range(DEPTH):
        h = rms_norm(x, norm_g[i])
        j = i // N_MIXERS
        if i % N_MIXERS == 0:
            y = mla_mixer(h, positions, mla_w_in[j], mla_g_cq[j], mla_w_uq[j], mla_g_ckv[j],
                          mla_w_ukv[j], mla_g_q[j], mla_g_k[j], mla_w_out[j])
        else:
            y = nsa_mixer(h, positions, nsa_w_in[j], nsa_g_q[j], nsa_g_k[j], nsa_pe_k[j],
                          nsa_w1_k[j], nsa_w2_k[j], nsa_pe_v[j], nsa_w1_v[j], nsa_w2_v[j],
                          nsa_w_out[j])
        x = x + y
    return x
```

```cpp
#include <hip/hip_runtime.h>
#include <stdint.h>
#include <stdio.h>

typedef unsigned short bf16_t;

constexpr int T = 16384, DM = 1024, NB = 4, SEQ = 4096;
constexpr float EPS = 1e-6f;
constexpr int M_INP = 2816, M_IN = 2752, M_CKV = 384, M_KPE = 640, M_Z = 704;
constexpr int N_INP = 4608, N_IN = 4528;
constexpr int N_Q = 0, N_KC = 1536, N_VC = 1920, N_KS = 2176, N_VS = 2560, N_KW = 2816, N_VW = 3200, N_GL = 3456, N_Z = 3504;
constexpr int NCMP = 255;
constexpr float LOG2E = 1.4426950408889634f;
constexpr float M_SCL2 = 0.07216878364870322f * LOG2E;
constexpr float N_SCL2 = 0.10206207261596575f * LOG2E;

constexpr size_t MiB = 1u << 20;
constexpr size_t WS_CTL = 0;
constexpr size_t WS_COSM = 1 * MiB, WS_SINM = 3 * MiB;
constexpr size_t WS_COSN = 5 * MiB, WS_SINN = 6 * MiB;
constexpr size_t WS_BIAS = 7 * MiB - 4096;
constexpr size_t WS_SSQX = 7 * MiB;
constexpr size_t WS_SSQ1 = 8 * MiB;
constexpr size_t WS_SSQKN = 10 * MiB;
constexpr size_t WS_KPES = 12 * MiB;
constexpr size_t WS_KCMP = 14 * MiB;
constexpr size_t WS_VCMP = 15 * MiB;
constexpr size_t WS_W = 16 * MiB;
constexpr size_t WSZ_MLA = (size_t)(2816 * 1024 + 3072 * 384 + 4096 * 256 + 1024 * 2048) * 2;
constexpr size_t WSZ_NSA = (size_t)(4608 * 1024 + 96 * 3072 + 96 * 96 + 64 * 2048 + 64 * 64 + 1024 * 1024) * 2;
constexpr size_t WS_XB = 68 * MiB;
constexpr size_t WS_P1 = 100 * MiB;
constexpr size_t WS_KVH = 188 * MiB;
static_assert(WS_W + 2 * (WSZ_MLA + WSZ_NSA) <= WS_XB, "weights fit");

struct MlaW { bf16_t *win, *wuq, *wukv, *wout; };
struct NsaW { bf16_t *win, *w1k, *w2k, *w1v, *w2v, *wout; float *bk, *bv; };
__host__ __device__ inline MlaW mla_w(unsigned char* ws, int j) {
    bf16_t* p = (bf16_t*)(ws + WS_W + (size_t)j * (WSZ_MLA + WSZ_NSA));
    MlaW w; w.win = p; w.wuq = w.win + 2816 * 1024; w.wukv = w.wuq + 3072 * 384; w.wout = w.wukv + 4096 * 256; return w;
}
__host__ __device__ inline NsaW nsa_w(unsigned char* ws, int j) {
    bf16_t* p = (bf16_t*)(ws + WS_W + (size_t)j * (WSZ_MLA + WSZ_NSA) + WSZ_MLA);
    NsaW w; w.win = p; w.w1k = w.win + 4608 * 1024; w.w2k = w.w1k + 96 * 3072; w.w1v = w.w2k + 96 * 96; w.w2v = w.w1v + 64 * 2048; w.wout = w.w2v + 64 * 64;
    w.bk = (float*)(ws + WS_BIAS) + j * 160; w.bv = w.bk + 96; return w;
}

enum { I_X = 0, I_POS, I_NORMG, I_MWIN, I_MGCQ, I_MWUQ, I_MGCKV, I_MWUKV, I_MGQ, I_MGK, I_MWOUT,
       I_NWIN, I_NGQ, I_NGK, I_NPEK, I_NW1K, I_NW2K, I_NPEV, I_NW1V, I_NW2V, I_NWOUT, N_INPUTS };

__device__ __forceinline__ float bf2f(bf16_t v) { return __uint_as_float((unsigned)v << 16); }
__device__ __forceinline__ bf16_t f2bf(float f) { unsigned u = __float_as_uint(f); return (bf16_t)((u + 0x7fffu + ((u >> 16) & 1u)) >> 16); }
__device__ __forceinline__ float wave_sum(float v) {
#pragma unroll
    for (int o = 1; o < 64; o <<= 1) v += __shfl_xor(v, o);
    return v;
}
__device__ __forceinline__ float wave_max(float v) {
#pragma unroll
    for (int o = 1; o < 64; o <<= 1) v = fmaxf(v, __shfl_xor(v, o));
    return v;
}

__constant__ float c_invf32[32] = {1.000000000e+00f, 6.636012793e-01f, 4.403665960e-01f, 2.922278047e-01f, 1.939227432e-01f, 1.286873668e-01f, 8.539710194e-02f, 5.666962266e-02f, 3.760603070e-02f, 2.495540865e-02f, 1.656043902e-02f, 1.098952908e-02f, 7.292664610e-03f, 4.839421250e-03f, 3.211445874e-03f, 2.131119603e-03f, 1.414213562e-03f, 9.384738514e-04f, 6.227723788e-04f, 4.132725589e-04f, 2.742481884e-04f, 1.819914323e-04f, 1.207697351e-04f, 8.014294872e-05f, 5.318296098e-05f, 3.529227615e-05f, 2.341999971e-05f, 1.554154005e-05f, 1.031338616e-05f, 6.843975370e-06f, 4.541670478e-06f, 3.013858077e-06f};
__constant__ float c_invf12[12] = {1.000000000e+00f, 3.350316584e-01f, 1.122462004e-01f, 3.760603070e-02f, 1.259920839e-02f, 4.221134819e-03f, 1.414213562e-03f, 4.738064308e-04f, 1.587400620e-04f, 5.318296098e-05f, 1.781797801e-05f, 5.969583526e-06f};
namespace nv {

__device__ __forceinline__ void sincos_rev(float ang, float& s, float& c) {
    double r = (double)ang * 0.15915494309189535; r -= floor(r);
    const float fr = (float)r; s = __builtin_amdgcn_sinf(fr); c = __builtin_amdgcn_cosf(fr);
}

__global__ void k_transpose(const float* __restrict__ W, const float* __restrict__ g, bf16_t* __restrict__ WT, int K, int N, int Npad) {
    const size_t total = (size_t)Npad * K;
    for (size_t i = (size_t)blockIdx.x * blockDim.x + threadIdx.x; i < total; i += (size_t)gridDim.x * blockDim.x) {
        const int n = (int)(i / K), k = (int)(i % K); float v = 0.f;
        if (n < N) { v = W[(size_t)k * N + n]; if (g) v *= g[k]; }
        WT[i] = f2bf(v);
    }
}
__global__ void k_rope_tables(const int* __restrict__ pos, float* cosM, float* sinM, float* cosN, float* sinN) {
    const int i = blockIdx.x * blockDim.x + threadIdx.x;
    if (i < T * 32) { const int t = i >> 5, f = i & 31; float s, c; sincos_rev((float)pos[t] * c_invf32[f], s, c); cosM[i] = c; sinM[i] = s; }
    if (i < T * 12) { const int t = i / 12, f = i % 12; float s, c; sincos_rev((float)pos[t] * c_invf12[f], s, c); cosN[i] = c; sinN[i] = s; }
}
__global__ void k_x_to_bf16(const float* __restrict__ x, bf16_t* __restrict__ xb, float* __restrict__ ssqx) {
    const int row = blockIdx.x * (blockDim.x >> 6) + (threadIdx.x >> 6), lane = threadIdx.x & 63;
    if (row >= T) return;
    float s = 0.f;
    for (int c = lane; c < DM; c += 64) { const bf16_t b = f2bf(x[(size_t)row * DM + c]); xb[(size_t)row * DM + c] = b; const float v = bf2f(b); s += v * v; }
    s = wave_sum(s);
    if (lane == 0) { ssqx[row] = s; ssqx[T + row] = 0.f; ssqx[2 * T + row] = 0.f; ssqx[3 * T + row] = 0.f; }
}
__global__ void k_ssqx(const bf16_t* __restrict__ xb, float* __restrict__ ssqx) {
    const int row = blockIdx.x * (blockDim.x >> 6) + (threadIdx.x >> 6), lane = threadIdx.x & 63;
    if (row >= T) return;
    float s = 0.f;
    for (int c = lane; c < DM; c += 64) { const float v = bf2f(xb[(size_t)row * DM + c]); s += v * v; }
    s = wave_sum(s);
    if (lane == 0) { ssqx[row] = s; ssqx[T + row] = 0.f; ssqx[2 * T + row] = 0.f; ssqx[3 * T + row] = 0.f; }
}
__global__ void k_bias(const float* __restrict__ pe, const float* __restrict__ w1, float* __restrict__ bias, int R, int N) {
    const int j = blockIdx.x * blockDim.x + threadIdx.x; if (j >= N) return;
    float s = 0.f; for (int r = 0; r < R; ++r) s += pe[r] * w1[(size_t)r * N + j];
    bias[j] = s;
}

struct EpiRowScale {
    bf16_t* out; int ldc; const float* ssq; int nslot; float inv_n;
    __device__ void operator()(int m, int n, float acc) const {
        float s = 0.f; for (int i = 0; i < nslot; ++i) s += ssq[(size_t)i * T + m];
        out[(size_t)m * ldc + n] = f2bf(acc * rsqrtf(s * inv_n + EPS));
    }
};
struct EpiPlain { bf16_t* out; int ldc; __device__ void operator()(int m, int n, float acc) const { out[(size_t)m * ldc + n] = f2bf(acc); } };
struct EpiResid {
    const float* xf; bf16_t* xb; float* outf;
    __device__ void operator()(int m, int n, float acc) const {
        const size_t i = (size_t)m * DM + n; const float r = xf ? xf[i] : bf2f(xb[i]); const float v = r + acc;
        if (outf) outf[i] = v; else xb[i] = f2bf(v);
    }
};
template <class Epi>
__global__ void k_gemm(const bf16_t* __restrict__ A, int lda, const bf16_t* __restrict__ Bt, int K, Epi epi) {
    const int n = blockIdx.x * 16 + threadIdx.x, m = blockIdx.y * 16 + threadIdx.y;
    const uint4* a = (const uint4*)(A + (size_t)m * lda); const uint4* b = (const uint4*)(Bt + (size_t)n * K);
    float acc = 0.f;
    for (int k = 0; k < K / 8; ++k) {
        const uint4 av = a[k], bv = b[k];
        const unsigned aw[4] = {av.x, av.y, av.z, av.w}, bw[4] = {bv.x, bv.y, bv.z, bv.w};
#pragma unroll
        for (int i = 0; i < 4; ++i) {
            acc += __uint_as_float(aw[i] << 16) * __uint_as_float(bw[i] << 16);
            acc += __uint_as_float(aw[i] & 0xffff0000u) * __uint_as_float(bw[i] & 0xffff0000u);
        }
    }
    epi(m, n, acc);
}
__global__ void k_ssq_cols(const bf16_t* __restrict__ src, int ld, int c0, int nc, float* __restrict__ dst, int nzero) {
    const int row = blockIdx.x * blockDim.x + threadIdx.x; if (row >= T) return;
    float s = 0.f; for (int c = 0; c < nc; ++c) { const float v = bf2f(src[(size_t)row * ld + c0 + c]); s += v * v; }
    dst[row] = s; for (int z = 1; z <= nzero; ++z) dst[(size_t)z * T + row] = 0.f;
}
__global__ void k_ssq_kn(const bf16_t* __restrict__ kvh, float* __restrict__ ssqkn) {
    const int i = blockIdx.x * blockDim.x + threadIdx.x; if (i >= T * 8) return;
    const int t = i >> 3, hl = i & 7; float s = 0.f;
    for (int c = 0; c < 128; ++c) { const float v = bf2f(kvh[(size_t)t * 2048 + hl * 256 + c]); s += v * v; }
    float* d = ssqkn + (size_t)hl * 4 * T; d[t] = s; d[T + t] = 0.f; d[2 * T + t] = 0.f; d[3 * T + t] = 0.f;
}

__global__ void k_kpes(const bf16_t* __restrict__ p1, const float* __restrict__ gk, const float* __restrict__ cosM, const float* __restrict__ sinM, bf16_t* __restrict__ kpes) {
    const int i = blockIdx.x * blockDim.x + threadIdx.x; if (i >= T * 32) return;
    const int t = i >> 5, f = i & 31;
    const float a = bf2f(p1[(size_t)t * M_INP + M_KPE + f]) * gk[f], b = bf2f(p1[(size_t)t * M_INP + M_KPE + 32 + f]) * gk[32 + f];
    const float c = cosM[i], s = sinM[i];
    kpes[(size_t)t * 64 + f] = f2bf(a * c - b * s); kpes[(size_t)t * 64 + 32 + f] = f2bf(b * c + a * s);
}
__global__ void __launch_bounds__(64) k_mla_attn(const bf16_t* __restrict__ qh, const bf16_t* __restrict__ kvh, const bf16_t* __restrict__ kpes, bf16_t* p1,
                                                 const float* __restrict__ ssq1, const float* __restrict__ ssqkn, const float* __restrict__ gq, const float* __restrict__ gk,
                                                 const float* __restrict__ cosM, const float* __restrict__ sinM, int half) {
    __shared__ float qe[192]; __shared__ float pb[64];
    const int lane = threadIdx.x; const int q = blockIdx.x % SEQ, hl = (blockIdx.x / SEQ) % 8, b = blockIdx.x / (SEQ * 8);
    const int h = half * 8 + hl; const size_t row = (size_t)b * SEQ + q;
    float v0 = bf2f(qh[row * 1536 + hl * 192 + lane]), v1 = bf2f(qh[row * 1536 + hl * 192 + 64 + lane]), v2 = bf2f(qh[row * 1536 + hl * 192 + 128 + lane]);
    const float msq = wave_sum(v0 * v0 + v1 * v1 + v2 * v2) * (1.f / 192.f);
    float sscq = 0.f; for (int s = 0; s < 12; ++s) sscq += ssq1[(size_t)s * T + row];
    const float a = rsqrtf(sscq * (1.f / 384.f) + EPS);
    const float sc = a * rsqrtf(a * a * msq + EPS);
    v0 *= sc * gq[lane]; v1 *= sc * gq[64 + lane]; v2 *= sc * gq[128 + lane];
    qe[lane] = v0; qe[64 + lane] = v1 * gk[64 + lane] * M_SCL2; qe[128 + lane] = v2 * gk[128 + lane] * M_SCL2;
    __syncthreads();
    if (lane < 32) { const float x1 = qe[lane], x2 = qe[32 + lane], c = cosM[row * 32 + lane], s = sinM[row * 32 + lane];
        qe[lane] = (x1 * c - x2 * s) * M_SCL2; qe[32 + lane] = (x2 * c + x1 * s) * M_SCL2; }
    __syncthreads();
    float m = -INFINITY, l = 0.f, o0 = 0.f, o1 = 0.f;
    for (int kb = 0; kb <= q; kb += 64) {
        const int key = kb + lane; const size_t krow = (size_t)b * SEQ + key;
        float s = -INFINITY;
        if (key <= q) {
            float dot = 0.f;
            for (int d = 0; d < 64; ++d) dot += qe[d] * bf2f(kpes[krow * 64 + d]);
            for (int d = 0; d < 128; ++d) dot += qe[64 + d] * bf2f(kvh[krow * 2048 + hl * 256 + d]);
            float ss = ssq1[(size_t)20 * T + krow] + ssq1[(size_t)21 * T + krow];
            for (int w = 0; w < 4; ++w) ss += ssqkn[((size_t)hl * 4 + w) * T + krow];
            s = dot * rsqrtf(ss * (1.f / 192.f) + EPS);
        }
        const float mn = fmaxf(m, wave_max(s));
        const float al = exp2f(m - mn), p = exp2f(s - mn);
        l = l * al + wave_sum(p); pb[lane] = p; __syncthreads();
        o0 *= al; o1 *= al;
        const int nk = min(64, q - kb + 1);
        for (int k = 0; k < nk; ++k) { const size_t vr = ((size_t)b * SEQ + kb + k) * 2048 + hl * 256 + 128;
            o0 += pb[k] * bf2f(kvh[vr + lane]); o1 += pb[k] * bf2f(kvh[vr + 64 + lane]); }
        m = mn; __syncthreads();
    }
    const float il = 1.f / l;
    bf16_t* zp = p1 + row * M_INP + M_Z + h * 128;
    const float z0 = bf2f(zp[lane]), z1 = bf2f(zp[64 + lane]);
    zp[lane] = f2bf(o0 * il * z0 / (1.f + __expf(-z0))); zp[64 + lane] = f2bf(o1 * il * z1 / (1.f + __expf(-z1)));
}

__global__ void k_nsa_post(bf16_t* p1, const float* __restrict__ gq, const float* __restrict__ gk, const float* __restrict__ cosN, const float* __restrict__ sinN) {
    const int i = blockIdx.x * blockDim.x + threadIdx.x; if (i >= T * 24) return;
    const int t = i / 24, u = i % 24;
    bf16_t* p; const float* g; float post = 1.f;
    if (u < 16) { p = p1 + (size_t)t * N_INP + N_Q + u * 96; g = gq; post = N_SCL2; }
    else if (u < 20) { p = p1 + (size_t)t * N_INP + N_KS + (u - 16) * 96; g = gk + 96; }
    else { p = p1 + (size_t)t * N_INP + N_KW + (u - 20) * 96; g = gk + 192; }
    float ss = 0.f; for (int d = 0; d < 96; ++d) { const float v = bf2f(p[d]); ss += v * v; }
    const float r = rsqrtf(ss * (1.f / 96.f) + EPS);
    for (int f = 0; f < 12; ++f) { const float a = bf2f(p[f]) * r * g[f], b = bf2f(p[12 + f]) * r * g[12 + f], c = cosN[t * 12 + f], s = sinN[t * 12 + f];
        p[f] = f2bf((a * c - b * s) * post); p[12 + f] = f2bf((b * c + a * s) * post); }
    for (int d = 24; d < 96; ++d) p[d] = f2bf(bf2f(p[d]) * r * g[d] * post);
}
__global__ void __launch_bounds__(96) k_compress_k(const bf16_t* __restrict__ p1, const bf16_t* __restrict__ w1t, const bf16_t* __restrict__ w2t, const float* __restrict__ bias,
                                                   const float* __restrict__ gk0, const float* __restrict__ cosN, const float* __restrict__ sinN, bf16_t* __restrict__ kcmp) {
    __shared__ float hid[96]; __shared__ float o[96]; __shared__ float red[96];
    const int j = threadIdx.x, n = blockIdx.x % 256, g = (blockIdx.x / 256) % 4, b = blockIdx.x / 1024;
    bf16_t* dst = kcmp + (((size_t)b * 4 + g) * 256 + n) * 96;
    if (n == 255) { dst[j] = 0; return; }
    float s = bias[j];
    for (int l = 0; l < 32; ++l) { const bf16_t* src = p1 + ((size_t)b * SEQ + 16 * n + l) * N_INP + N_KC + g * 96;
        for (int d = 0; d < 96; ++d) s += bf2f(src[d]) * bf2f(w1t[(size_t)j * 3072 + l * 96 + d]); }
    hid[j] = bf2f(f2bf(s / (1.f + __expf(-s))));
    __syncthreads();
    float y = 0.f; for (int k = 0; k < 96; ++k) y += hid[k] * bf2f(w2t[j * 96 + k]);
    red[j] = y * y; o[j] = y; __syncthreads();
    float ss = 0.f; for (int k = 0; k < 96; ++k) ss += red[k];
    const float r = rsqrtf(ss * (1.f / 96.f) + EPS);
    o[j] = y * r * gk0[j]; __syncthreads();
    const int tp = b * SEQ + 16 * n + 31;
    float v = o[j];
    if (j < 12) v = o[j] * cosN[tp * 12 + j] - o[j + 12] * sinN[tp * 12 + j];
    else if (j < 24) v = o[j] * cosN[tp * 12 + j - 12] + o[j - 12] * sinN[tp * 12 + j - 12];
    dst[j] = f2bf(v);
}
__global__ void __launch_bounds__(64) k_compress_v(const bf16_t* __restrict__ p1, const bf16_t* __restrict__ w1t, const bf16_t* __restrict__ w2t, const float* __restrict__ bias, bf16_t* __restrict__ vcmp) {
    __shared__ float hid[64];
    const int j = threadIdx.x, n = blockIdx.x % 256, g = (blockIdx.x / 256) % 4, b = blockIdx.x / 1024;
    bf16_t* dst = vcmp + (((size_t)b * 4 + g) * 256 + n) * 64;
    if (n == 255) { dst[j] = 0; return; }
    float s = bias[j];
    for (int l = 0; l < 32; ++l) { const bf16_t* src = p1 + ((size_t)b * SEQ + 16 * n + l) * N_INP + N_VC + g * 64;
        for (int d = 0; d < 64; ++d) s += bf2f(src[d]) * bf2f(w1t[(size_t)j * 2048 + l * 64 + d]); }
    hid[j] = bf2f(f2bf(s / (1.f + __expf(-s))));
    __syncthreads();
    float y = 0.f; for (int k = 0; k < 64; ++k) y += hid[k] * bf2f(w2t[j * 64 + k]);
    dst[j] = f2bf(y);
}
__global__ void __launch_bounds__(256) k_nsa_attn(bf16_t* p1, const bf16_t* __restrict__ kcmp, const bf16_t* __restrict__ vcmp) {
    __shared__ float qs[4][96]; __shared__ float pc[4][256]; __shared__ float pb[4][64]; __shared__ float scj[64]; __shared__ unsigned long long selm;
    const int w = threadIdx.x >> 6, lane = threadIdx.x & 63;
    const int g = blockIdx.x & 3, tg = blockIdx.x >> 2, b = tg / SEQ, t = tg % SEQ;
    const size_t row = (size_t)b * SEQ + t; const int h = g * 4 + w;
    const bf16_t* prow = p1 + row * N_INP;
    for (int d = lane; d < 96; d += 64) qs[w][d] = bf2f(prow[N_Q + h * 96 + d]);
    __syncthreads();
    const bf16_t* kc = kcmp + ((size_t)b * 4 + g) * 256 * 96; const bf16_t* vc = vcmp + ((size_t)b * 4 + g) * 256 * 64;
    float sv[4]; float mx = -INFINITY;
#pragma unroll
    for (int kk = 0; kk < 4; ++kk) { const int n = lane + 64 * kk; float s = -INFINITY;
        if (n < NCMP && 16 * n + 31 <= t) { float dot = 0.f; for (int d = 0; d < 96; ++d) dot += qs[w][d] * bf2f(kc[n * 96 + d]); s = dot; }
        sv[kk] = s; mx = fmaxf(mx, s); }
    mx = wave_max(mx); if (mx == -INFINITY) mx = 0.f;
    float es = 0.f;
#pragma unroll
    for (int kk = 0; kk < 4; ++kk) { sv[kk] = exp2f(sv[kk] - mx); es += sv[kk]; }
    es = wave_sum(es); const float inv = 1.f / (es > 0.f ? es : 1.f);
#pragma unroll
    for (int kk = 0; kk < 4; ++kk) pc[w][lane + 64 * kk] = sv[kk] * inv;
    __syncthreads();
    float oc = 0.f; for (int n = 0; n < NCMP; ++n) oc += bf2f(f2bf(pc[w][n])) * bf2f(vc[n * 64 + lane]);
    const int cur = t >> 6;
    if (w == 0) { const int j = lane; float im = 0.f;
        for (int n = 4 * j - 1; n <= 4 * j + 3; ++n) if (n >= 0 && n < NCMP) im += pc[0][n] + pc[1][n] + pc[2][n] + pc[3][n];
        const bool forced = (j == 0) || (j == cur) || (j == cur - 1);
        scj[j] = forced ? 1e4f : ((64 * j <= t) ? im : -1.f); }
    __syncthreads();
    if (w == 0) { const float me = scj[lane]; int rank = 0;
        for (int j2 = 0; j2 < 64; ++j2) { const float o = scj[j2]; rank += (o > me || (o == me && j2 < lane)) ? 1 : 0; }
        const unsigned long long mk = __ballot(rank < 16); if (lane == 0) selm = mk; }
    __syncthreads();
    const unsigned long long mask = selm;
    float m = -INFINITY, l = 0.f, os = 0.f;
    for (int j = 0; j < 64; ++j) { if (!((mask >> j) & 1ull)) continue;
        const int key = 64 * j + lane; float s = -INFINITY;
        if (key <= t) { const bf16_t* kp = p1 + ((size_t)b * SEQ + key) * N_INP + N_KS + g * 96; float dot = 0.f; for (int d = 0; d < 96; ++d) dot += qs[w][d] * bf2f(kp[d]); s = dot; }
        const float bm = wave_max(s);
        if (bm != -INFINITY) { const float mn = fmaxf(m, bm), al = exp2f(m - mn), p = exp2f(s - mn); l = l * al + wave_sum(p); os *= al; m = mn; pb[w][lane] = bf2f(f2bf(p)); }
        else pb[w][lane] = 0.f;
        __syncthreads();
        for (int k = 0; k < 64; ++k) { const int kk = 64 * j + k; if (kk <= t) os += pb[w][k] * bf2f(p1[((size_t)b * SEQ + kk) * N_INP + N_VS + g * 64 + lane]); }
        __syncthreads();
    }
    os = l > 0.f ? os / l : 0.f;
    float mw = -INFINITY, lw = 0.f, ow = 0.f;
    for (int c = 0; c < 8; ++c) { const int key = t - 511 + 64 * c + lane; float s = -INFINITY;
        if (key >= 0) { const bf16_t* kp = p1 + ((size_t)b * SEQ + key) * N_INP + N_KW + g * 96; float dot = 0.f; for (int d = 0; d < 96; ++d) dot += qs[w][d] * bf2f(kp[d]); s = dot; }
        const float bm = wave_max(s);
        if (bm != -INFINITY) { const float mn = fmaxf(mw, bm), al = exp2f(mw - mn), p = exp2f(s - mn); lw = lw * al + wave_sum(p); ow *= al; mw = mn; pb[w][lane] = bf2f(f2bf(p)); }
        else pb[w][lane] = 0.f;
        __syncthreads();
        for (int k = 0; k < 64; ++k) { const int kk = t - 511 + 64 * c + k; if (kk >= 0) ow += pb[w][k] * bf2f(p1[((size_t)b * SEQ + kk) * N_INP + N_VW + g * 64 + lane]); }
        __syncthreads();
    }
    ow = lw > 0.f ? ow / lw : 0.f;
    const float g0 = 1.f / (1.f + __expf(-bf2f(prow[N_GL + h * 3 + 0]))), g1 = 1.f / (1.f + __expf(-bf2f(prow[N_GL + h * 3 + 1]))), g2 = 1.f / (1.f + __expf(-bf2f(prow[N_GL + h * 3 + 2])));
    bf16_t* zp = p1 + row * N_INP + N_Z + h * 64 + lane; const float z = bf2f(*zp);
    *zp = f2bf((g0 * oc + g1 * os + g2 * ow) * z / (1.f + __expf(-z)));
}

}
struct Ctx {
    void* const* in; float* out; unsigned char* ws; hipStream_t st;
    const float* f(int i) const { return (const float*)in[i]; }
    bf16_t* xb() const { return (bf16_t*)(ws + WS_XB); }
    bf16_t* p1() const { return (bf16_t*)(ws + WS_P1); }
    bf16_t* kvh() const { return (bf16_t*)(ws + WS_KVH); }
    bf16_t* qh() const { return (bf16_t*)out; }
    bf16_t* kpes() const { return (bf16_t*)(ws + WS_KPES); }
    bf16_t* kcmp() const { return (bf16_t*)(ws + WS_KCMP); }
    bf16_t* vcmp() const { return (bf16_t*)(ws + WS_VCMP); }
    float* ssqx() const { return (float*)(ws + WS_SSQX); }
    float* ssq1() const { return (float*)(ws + WS_SSQ1); }
    float* ssqkn() const { return (float*)(ws + WS_SSQKN); }
    float* cosM() const { return (float*)(ws + WS_COSM); }
    float* sinM() const { return (float*)(ws + WS_SINM); }
    float* cosN() const { return (float*)(ws + WS_COSN); }
    float* sinN() const { return (float*)(ws + WS_SINN); }
};

static void naive_prologue(const Ctx& c) {
    for (int j = 0; j < 2; ++j) {
        const MlaW mw = mla_w(c.ws, j); const NsaW nw = nsa_w(c.ws, j);
        nv::k_transpose<<<2048, 256, 0, c.st>>>(c.f(I_MWIN) + (size_t)j * 1024 * M_IN, c.f(I_NORMG) + (2 * j) * DM, mw.win, 1024, M_IN, M_INP);
        nv::k_transpose<<<2048, 256, 0, c.st>>>(c.f(I_MWUQ) + (size_t)j * 384 * 3072, c.f(I_MGCQ) + j * 384, mw.wuq, 384, 3072, 3072);
        nv::k_transpose<<<2048, 256, 0, c.st>>>(c.f(I_MWUKV) + (size_t)j * 256 * 4096, c.f(I_MGCKV) + j * 256, mw.wukv, 256, 4096, 4096);
        nv::k_transpose<<<2048, 256, 0, c.st>>>(c.f(I_MWOUT) + (size_t)j * 2048 * 1024, nullptr, mw.wout, 2048, 1024, 1024);
        nv::k_transpose<<<2048, 256, 0, c.st>>>(c.f(I_NWIN) + (size_t)j * 1024 * N_IN, c.f(I_NORMG) + (2 * j + 1) * DM, nw.win, 1024, N_IN, N_INP);
        nv::k_transpose<<<256, 256, 0, c.st>>>(c.f(I_NW1K) + (size_t)j * 3072 * 96, nullptr, nw.w1k, 3072, 96, 96);
        nv::k_transpose<<<16, 256, 0, c.st>>>(c.f(I_NW2K) + (size_t)j * 96 * 96, nullptr, nw.w2k, 96, 96, 96);
        nv::k_transpose<<<256, 256, 0, c.st>>>(c.f(I_NW1V) + (size_t)j * 2048 * 64, nullptr, nw.w1v, 2048, 64, 64);
        nv::k_transpose<<<16, 256, 0, c.st>>>(c.f(I_NW2V) + (size_t)j * 64 * 64, nullptr, nw.w2v, 64, 64, 64);
        nv::k_transpose<<<2048, 256, 0, c.st>>>(c.f(I_NWOUT) + (size_t)j * 1024 * 1024, nullptr, nw.wout, 1024, 1024, 1024);
        nv::k_bias<<<1, 96, 0, c.st>>>(c.f(I_NPEK) + j * 32 * 96, c.f(I_NW1K) + (size_t)j * 3072 * 96, nw.bk, 3072, 96);
        nv::k_bias<<<1, 64, 0, c.st>>>(c.f(I_NPEV) + j * 32 * 64, c.f(I_NW1V) + (size_t)j * 2048 * 64, nw.bv, 2048, 64);
    }
    nv::k_rope_tables<<<(T * 32 + 255) / 256, 256, 0, c.st>>>((const int*)c.in[I_POS], c.cosM(), c.sinM(), c.cosN(), c.sinN());
    nv::k_x_to_bf16<<<T / 4, 256, 0, c.st>>>(c.f(I_X), c.xb(), c.ssqx());
}
static void naive_mla_g1(const Ctx& c, int j) {
    const MlaW w = mla_w(c.ws, j);
    nv::EpiRowScale e{c.p1(), M_INP, c.ssqx(), 4, 1.f / 1024.f};
    nv::k_gemm<<<dim3(M_INP / 16, T / 16), dim3(16, 16), 0, c.st>>>(c.xb(), DM, w.win, 1024, e);
    nv::k_ssq_cols<<<T / 256, 256, 0, c.st>>>(c.p1(), M_INP, 0, 384, c.ssq1(), 11);
    nv::k_ssq_cols<<<T / 256, 256, 0, c.st>>>(c.p1(), M_INP, M_CKV, 256, c.ssq1() + (size_t)12 * T, 7);
    nv::k_ssq_cols<<<T / 256, 256, 0, c.st>>>(c.p1(), M_INP, M_KPE, 64, c.ssq1() + (size_t)20 * T, 1);
}
static void naive_mla_g2(const Ctx& c, int j, int half) {
    const MlaW w = mla_w(c.ws, j);
    if (half == 0) nv::k_kpes<<<T * 32 / 256, 256, 0, c.st>>>(c.p1(), c.f(I_MGK) + j * 192, c.cosM(), c.sinM(), c.kpes());
    nv::EpiPlain eq{c.qh(), 1536};
    nv::k_gemm<<<dim3(1536 / 16, T / 16), dim3(16, 16), 0, c.st>>>(c.p1(), M_INP, w.wuq + (size_t)half * 1536 * 384, 384, eq);
    nv::EpiRowScale ek{c.kvh(), 2048, c.ssq1() + (size_t)12 * T, 8, 1.f / 256.f};
    nv::k_gemm<<<dim3(2048 / 16, T / 16), dim3(16, 16), 0, c.st>>>(c.p1() + M_CKV, M_INP, w.wukv + (size_t)half * 2048 * 256, 256, ek);
    nv::k_ssq_kn<<<T * 8 / 256, 256, 0, c.st>>>(c.kvh(), c.ssqkn());
}
static void naive_mla_attn(const Ctx& c, int j, int half) {
    nv::k_mla_attn<<<NB * 8 * SEQ, 64, 0, c.st>>>(c.qh(), c.kvh(), c.kpes(), c.p1(), c.ssq1(), c.ssqkn(), c.f(I_MGQ) + j * 192, c.f(I_MGK) + j * 192, c.cosM(), c.sinM(), half);
}
static void naive_outproj(const Ctx& c, const bf16_t* A, int lda, const bf16_t* wt, int K, bool first, bool last) {
    nv::EpiResid e{first ? c.f(I_X) : nullptr, c.xb(), last ? c.out : nullptr};
    nv::k_gemm<<<dim3(DM / 16, T / 16), dim3(16, 16), 0, c.st>>>(A, lda, wt, K, e);
    if (!last) nv::k_ssqx<<<T / 4, 256, 0, c.st>>>(c.xb(), c.ssqx());
}
static void naive_nsa_g1(const Ctx& c, int j) {
    const NsaW w = nsa_w(c.ws, j);
    nv::EpiRowScale e{c.p1(), N_INP, c.ssqx(), 4, 1.f / 1024.f};
    nv::k_gemm<<<dim3(N_INP / 16, T / 16), dim3(16, 16), 0, c.st>>>(c.xb(), DM, w.win, 1024, e);
}
static void naive_nsa_post(const Ctx& c, int j) {
    const NsaW w = nsa_w(c.ws, j);
    nv::k_nsa_post<<<T * 24 / 256, 256, 0, c.st>>>(c.p1(), c.f(I_NGQ) + j * 96, c.f(I_NGK) + j * 288, c.cosN(), c.sinN());
    nv::k_compress_k<<<NB * 4 * 256, 96, 0, c.st>>>(c.p1(), w.w1k, w.w2k, w.bk, c.f(I_NGK) + j * 288, c.cosN(), c.sinN(), c.kcmp());
    nv::k_compress_v<<<NB * 4 * 256, 64, 0, c.st>>>(c.p1(), w.w1v, w.w2v, w.bv, c.vcmp());
}
static void naive_nsa_attn(const Ctx& c) { nv::k_nsa_attn<<<T * 4, 256, 0, c.st>>>(c.p1(), c.kcmp(), c.vcmp()); }

extern "C" void kernel_launch(void* const* d_in, const int* in_sizes, int n_in, void* d_out, int out_size, void* d_ws, size_t ws_size, hipStream_t stream) {
    if (n_in != N_INPUTS || out_size != T * DM || ws_size < 256 * MiB) { fprintf(stderr, "kernel_launch: unexpected shapes\n"); return; }
    Ctx c{d_in, (float*)d_out, (unsigned char*)d_ws, stream};
    naive_prologue(c);
    for (int L = 0; L < 4; ++L) {
        const int j = L >> 1;
        if ((L & 1) == 0) {
            naive_mla_g1(c, j);
            for (int half = 0; half < 2; ++half) { naive_mla_g2(c, j, half); naive_mla_attn(c, j, half); }
            naive_outproj(c, c.p1() + M_Z, M_INP, mla_w(c.ws, j).wout, 2048, L == 0, false);
        } else {
            naive_nsa_g1(c, j); naive_nsa_post(c, j); naive_nsa_attn(c);
            naive_outproj(c, c.p1() + N_Z, N_INP, nsa_w(c.ws, j).wout, 1024, false, L == 3);
        }
    }
}
```

```cpp
#include <hip/hip_runtime.h>
#include <stdint.h>
#include <stdio.h>

typedef unsigned short bf16_t;

constexpr int T = 16384, DM = 1024, NB = 4, SEQ = 4096;
constexpr float EPS = 1e-6f;
constexpr int M_INP = 2816, M_IN = 2752, M_CKV = 384, M_KPE = 640, M_Z = 704;
constexpr int N_INP = 4608, N_IN = 4528;
constexpr int N_Q = 0, N_KC = 1536, N_VC = 1920, N_KS = 2176, N_VS = 2560, N_KW = 2816, N_VW = 3200, N_GL = 3456, N_Z = 3504;
constexpr int NCMP = 255;
constexpr float LOG2E = 1.4426950408889634f;
constexpr float M_SCL2 = 0.07216878364870322f * LOG2E;
constexpr float N_SCL2 = 0.10206207261596575f * LOG2E;

constexpr size_t MiB = 1u << 20;
constexpr size_t WS_CTL = 0;
constexpr size_t WS_COSM = 1 * MiB, WS_SINM = 3 * MiB;
constexpr size_t WS_COSN = 5 * MiB, WS_SINN = 6 * MiB;
constexpr size_t WS_BIAS = 7 * MiB - 4096;
constexpr size_t WS_SSQX = 7 * MiB;
constexpr size_t WS_SSQ1 = 8 * MiB;
constexpr size_t WS_SSQKN = 252 * MiB;
constexpr size_t WS_KPES = 12 * MiB;
constexpr size_t WS_KCMP = 14 * MiB;
constexpr size_t WS_VCMP = 15 * MiB;
constexpr size_t WS_W = 16 * MiB;
constexpr size_t WSZ_MLA = (size_t)(2816 * 1024 + 3072 * 384 + 4096 * 256 + 1024 * 2048) * 2;
constexpr size_t WSZ_NSA = (size_t)(4608 * 1024 + 96 * 3072 + 96 * 96 + 64 * 2048 + 64 * 64 + 1024 * 1024) * 2;
constexpr size_t WS_XB = 68 * MiB;
constexpr size_t WS_P1 = 100 * MiB;
constexpr size_t WS_KVH = 188 * MiB;
static_assert(WS_W + 2 * (WSZ_MLA + WSZ_NSA) <= WS_XB, "weights fit");

struct MlaW { bf16_t *win, *wuq, *wukv, *wout; };
struct NsaW { bf16_t *win, *w1k, *w2k, *w1v, *w2v, *wout; float *bk, *bv; };
__host__ __device__ inline MlaW mla_w(unsigned char* ws, int j) {
    bf16_t* p = (bf16_t*)(ws + WS_W + (size_t)j * (WSZ_MLA + WSZ_NSA));
    MlaW w; w.win = p; w.wuq = w.win + 2816 * 1024; w.wukv = w.wuq + 3072 * 384; w.wout = w.wukv + 4096 * 256; return w;
}
__host__ __device__ inline NsaW nsa_w(unsigned char* ws, int j) {
    bf16_t* p = (bf16_t*)(ws + WS_W + (size_t)j * (WSZ_MLA + WSZ_NSA) + WSZ_MLA);
    NsaW w; w.win = p; w.w1k = w.win + 4608 * 1024; w.w2k = w.w1k + 96 * 3072; w.w1v = w.w2k + 96 * 96; w.w2v = w.w1v + 64 * 2048; w.wout = w.w2v + 64 * 64;
    w.bk = (float*)(ws + WS_BIAS) + j * 160; w.bv = w.bk + 96; return w;
}

enum { I_X = 0, I_POS, I_NORMG, I_MWIN, I_MGCQ, I_MWUQ, I_MGCKV, I_MWUKV, I_MGQ, I_MGK, I_MWOUT,
       I_NWIN, I_NGQ, I_NGK, I_NPEK, I_NW1K, I_NW2K, I_NPEV, I_NW1V, I_NW2V, I_NWOUT, N_INPUTS };

__device__ __forceinline__ float bf2f(bf16_t v) { return __uint_as_float((unsigned)v << 16); }
__device__ __forceinline__ bf16_t f2bf(float f) { unsigned u = __float_as_uint(f); return (bf16_t)((u + 0x7fffu + ((u >> 16) & 1u)) >> 16); }
template <int CTRL> __device__ __forceinline__ float dppf(float x) { return __int_as_float(__builtin_amdgcn_update_dpp(0, __float_as_int(x), CTRL, 0xf, 0xf, false)); }
__device__ __forceinline__ float get_xor1(float x) { return dppf<0xB1>(x); }
__device__ __forceinline__ float get_xor2(float x) { return dppf<0x4E>(x); }
__device__ __forceinline__ float sum_xor16(float x) { auto r = __builtin_amdgcn_permlane16_swap(__float_as_uint(x), __float_as_uint(x), false, false); return __uint_as_float(r[0]) + __uint_as_float(r[1]); }
__device__ __forceinline__ float sum_xor32(float x) { auto r = __builtin_amdgcn_permlane32_swap(__float_as_uint(x), __float_as_uint(x), false, false); return __uint_as_float(r[0]) + __uint_as_float(r[1]); }
__device__ __forceinline__ float get_xor32(float x, int hi) { auto r = __builtin_amdgcn_permlane32_swap(__float_as_uint(x), __float_as_uint(x), false, false); return __uint_as_float(hi ? r[0] : r[1]); }
__device__ __forceinline__ float wave_sum(float v) {
    v += get_xor1(v); v += get_xor2(v); v += dppf<0x124>(v); v += dppf<0x128>(v);
    return sum_xor32(sum_xor16(v));
}

__constant__ float c_invf32[32] = {1.000000000e+00f, 6.636012793e-01f, 4.403665960e-01f, 2.922278047e-01f, 1.939227432e-01f, 1.286873668e-01f, 8.539710194e-02f, 5.666962266e-02f, 3.760603070e-02f, 2.495540865e-02f, 1.656043902e-02f, 1.098952908e-02f, 7.292664610e-03f, 4.839421250e-03f, 3.211445874e-03f, 2.131119603e-03f, 1.414213562e-03f, 9.384738514e-04f, 6.227723788e-04f, 4.132725589e-04f, 2.742481884e-04f, 1.819914323e-04f, 1.207697351e-04f, 8.014294872e-05f, 5.318296098e-05f, 3.529227615e-05f, 2.341999971e-05f, 1.554154005e-05f, 1.031338616e-05f, 6.843975370e-06f, 4.541670478e-06f, 3.013858077e-06f};
__constant__ float c_invf12[12] = {1.000000000e+00f, 3.350316584e-01f, 1.122462004e-01f, 3.760603070e-02f, 1.259920839e-02f, 4.221134819e-03f, 1.414213562e-03f, 4.738064308e-04f, 1.587400620e-04f, 5.318296098e-05f, 1.781797801e-05f, 5.969583526e-06f};
#define GAS __attribute__((address_space(1)))
#define LAS __attribute__((address_space(3)))
typedef unsigned v4u __attribute__((ext_vector_type(4)));
typedef float f32x4 __attribute__((ext_vector_type(4)));
typedef short bf16x8 __attribute__((ext_vector_type(8)));
typedef GAS unsigned gu32;
typedef GAS unsigned long long gu64;
#define RLX_AGENT __ATOMIC_RELAXED, __HIP_MEMORY_SCOPE_AGENT
#define LDS_WAIT() asm volatile("s_waitcnt lgkmcnt(0)" ::: "memory")
#define VM_WAIT() asm volatile("s_waitcnt vmcnt(0)" ::: "memory")
__device__ __forceinline__ unsigned long long rt() { return __builtin_amdgcn_s_memrealtime(); }
__device__ __forceinline__ unsigned pk2(float lo, float hi) { return (unsigned)f2bf(lo) | ((unsigned)f2bf(hi) << 16); }

#define XB_TMO      128
#define XB_XCNT(j)  (256  + 64 * (j))
#define XB_XSUB(j)  (1280 + 64 * (j))
#define XB_XGEN(j)  (2304 + 64 * (j))
#define XB_TOP      3328
#define XB_TOPGEN   3392
#define XCD_BAR_WORDS 3456
#define XB_SPIN_CAP (1u << 18)

__device__ __forceinline__ unsigned xb_ld(unsigned* p)              { return __hip_atomic_load(p, __ATOMIC_RELAXED, __HIP_MEMORY_SCOPE_AGENT); }
__device__ __forceinline__ unsigned xb_add(unsigned* p, unsigned v) { return __hip_atomic_fetch_add(p, v, __ATOMIC_RELAXED, __HIP_MEMORY_SCOPE_AGENT); }
__device__ __forceinline__ unsigned xb_xcc_id() { return (unsigned)__builtin_amdgcn_s_getreg((3 << 11) | 20) & 0xFu; }
#define XB_SPIN(cond, bar) do { unsigned _sp = 0; while (cond) { __builtin_amdgcn_s_sleep(1); \
    if ((++_sp & 255u) == 0u) { if (xb_ld(&(bar)[XB_TMO])) break; if (_sp > XB_SPIN_CAP) { atomicAdd(&(bar)[XB_TMO], 1u); break; } } } } while (0)

struct XcdBarrier {
    unsigned* bar; unsigned x;
    volatile LAS unsigned* st;
};

__device__ __forceinline__ XcdBarrier xcd_barrier_post(unsigned* bar, volatile LAS unsigned* st) {
    XcdBarrier b; b.bar = bar; b.x = xb_xcc_id(); b.st = st;
    if (threadIdx.x == 0) (void)xb_add(&bar[XB_XCNT(b.x)], 1u);
    return b;
}
__device__ __forceinline__ void xcd_barrier_complete(unsigned* bar, unsigned x, unsigned& nloc, unsigned& nx) {
    const unsigned G = gridDim.x * gridDim.y * gridDim.z;
    unsigned sum, cnt, mine, sp = 0u;
    for (;;) {
        sum = 0u; cnt = 0u; mine = 0u;
#pragma unroll
        for (unsigned j = 0; j < 16; ++j) { const unsigned c = xb_ld(&bar[XB_XCNT(j)]); sum += c; cnt += (c > 0u) ? 1u : 0u; mine = (j == x) ? c : mine; }
        if (sum == G) break;
        __builtin_amdgcn_s_sleep(1);
        if ((++sp & 255u) == 0u) { if (xb_ld(&bar[XB_TMO])) break; if (sp > XB_SPIN_CAP) { atomicAdd(&bar[XB_TMO], 1u); break; } }
    }
    nloc = mine > 0u ? mine : 1u; nx = cnt > 0u ? cnt : 1u;
}

__device__ __forceinline__ void xcd_barrier(const XcdBarrier& b) {
    asm volatile("s_waitcnt vmcnt(0)" ::: "memory");
    __syncthreads();
    if (threadIdx.x == 0) {
        unsigned* bar = b.bar;
        __builtin_amdgcn_s_waitcnt(0);
        unsigned nloc = b.st[0], nx = b.st[1];
        if (nloc == 0u) { xcd_barrier_complete(bar, b.x, nloc, nx); b.st[0] = nloc; b.st[1] = nx; }
        const unsigned old = xb_add(&bar[XB_XSUB(b.x)], 1u);
        const unsigned gen = old / nloc;
        if (old + 1u == (gen + 1u) * nloc) {
            __builtin_amdgcn_fence(__ATOMIC_RELEASE, "agent");
            asm volatile("s_waitcnt vmcnt(0)" ::: "memory");
            const unsigned og = xb_add(&bar[XB_TOP], 1u);
            const unsigned tg = og / nx;
            if (og + 1u == (tg + 1u) * nx) xb_add(&bar[XB_TOPGEN], 1u);
            else XB_SPIN(xb_ld(&bar[XB_TOPGEN]) == tg, bar);
            __builtin_amdgcn_fence(__ATOMIC_ACQUIRE, "agent");
            xb_add(&bar[XB_XGEN(b.x)], 1u);
            asm volatile("s_waitcnt vmcnt(0)" ::: "memory");
        } else {
            XB_SPIN(xb_ld(&bar[XB_XGEN(b.x)]) == gen, bar);
            __builtin_amdgcn_fence(__ATOMIC_ACQUIRE, "agent");
            asm volatile("s_waitcnt vmcnt(0)" ::: "memory");
        }
    }
    __syncthreads();
}
namespace pg8 {
#define PG8_LAS __attribute__((address_space(3)))
typedef short bf16x8 __attribute__((ext_vector_type(8)));
typedef float f32x4 __attribute__((ext_vector_type(4)));
typedef unsigned u32x4 __attribute__((ext_vector_type(4)));
constexpr int BM = 256, BK = 64, HALF = 128, HTB = HALF * BK * 2  , STAGE_BYTES = 8 * HTB, NXCD = 8, WGM = 8;

__host__ __device__ __forceinline__ int lds_byte(int r, int c) { const int st = (r >> 4) * 2 + (c >> 5), rr = r & 15, cc = c & 31, ob = rr * 64 + cc * 2; return st * 1024 + (ob ^ (((ob >> 9) & 1) << 5)); }
__host__ __device__ __forceinline__ void stage_rc(int b, int& R, int& C) { const int st = b / 1024, sb = b % 1024, swz = sb ^ (((sb >> 9) & 1) << 5); R = (st >> 1) * 16 + swz / 64; C = (st & 1) * 32 + (swz % 64) / 2; }
__host__ __device__ __forceinline__ int perm32(int rho) { const int n = rho >> 4, i = rho & 15; return 8 * (i >> 2) + 4 * n + (i & 3); }

struct Unit { int pm, pn; };
struct Gemm { const bf16_t* A; const bf16_t* Bt; int M, N, K, lda; };

struct StaticOrder {
    int nM, nN, nwg, G, c;
    __host__ __device__ void init(int M, int N, int G_, int c_) { nM = M / BM; nN = N / BM; nwg = nM * nN; G = G_; c = c_; }
    __host__ __device__ bool next(int i, Unit& u) const {
        const long L = (long)i * G + c; if (L >= nwg) return false;
        int wgid = (int)L; { const int q = nwg / NXCD, r = nwg % NXCD, xcd = wgid % NXCD, off = wgid / NXCD; wgid = (xcd < r ? xcd * (q + 1) : r * (q + 1) + (xcd - r) * q) + off; }
        const int nig = WGM * nN, gid = wgid / nig, fm = gid * WGM, gsz = (nM - fm) < WGM ? (nM - fm) : WGM;
        u.pm = fm + ((wgid % nig) % gsz); u.pn = (wgid % nig) / gsz; return true;
    }
    __device__ __forceinline__ void a_ready(const Unit&, int) const {}
    __device__ __forceinline__ void done(const Unit&) const {}
};

template <class Epi, class Sched, bool ALIGN_EPI = false, bool SP2 = false>
__device__ __forceinline__ void gemm_phase(PG8_LAS unsigned char* lds, const Gemm g, const Sched& S, const Epi& E) {
    int tid_ = threadIdx.x; asm volatile("" : "+v"(tid_));
    const int tid = tid_, wid = __builtin_amdgcn_readfirstlane(tid >> 6), lane = tid & 63, wr = wid >> 2, wc = wid & 3, fr = lane & 15, fq = lane >> 4;
    const int K = g.K, nt = K / BK;
    unsigned voffA[2], voffB[2];
#pragma unroll
    for (int i = 0; i < 2; ++i) { int R, C; stage_rc(tid * 16 + i * 8192, R, C); const int Rb = Epi::PERM ? ((R & ~31) + perm32(R & 31)) : R;
        voffA[i] = (unsigned)(R * g.lda + C) * 2u; voffB[i] = (unsigned)(Rb * K + C) * 2u; }
    const size_t kstep = (size_t)(BK * 2);
    const size_t hstepA = (size_t)HALF * g.lda * 2, hstepB = (size_t)HALF * K * 2;
    const size_t tstepA = 2 * hstepA, tstepB = 2 * hstepB;
    const unsigned ldsw = (unsigned)wid * 1024u;
    const int aoff = lds_byte(wr * 64 + fr, fq * 8), boff = lds_byte(wc * 32 + fr, fq * 8);
#define PG8_SA(b, h) (((b) * 2 + (h)) * HTB)
#define PG8_SB(b, h) ((4 + (b) * 2 + (h)) * HTB)
#define PG8_STAGE(bufoff, gbase, voff) do { _Pragma("unroll") for (int _i = 0; _i < 2; ++_i) \
        __builtin_amdgcn_global_load_lds((const unsigned*)((const char*)(gbase) + (voff)[_i]), (PG8_LAS unsigned*)(lds + (bufoff) + ldsw + _i * 8192), 16, 0, 0); } while (0)
#define PG8_LDA(dst, b, h) do { _Pragma("unroll") for (int m = 0; m < 4; ++m) _Pragma("unroll") for (int k = 0; k < 2; ++k) dst[m][k] = *(const PG8_LAS bf16x8*)(lds + PG8_SA(b, h) + aoff + m * 2048 + k * 1024); } while (0)
#define PG8_LDB(dst, b, h) do { _Pragma("unroll") for (int n = 0; n < 2; ++n) _Pragma("unroll") for (int k = 0; k < 2; ++k) dst[n][k] = *(const PG8_LAS bf16x8*)(lds + PG8_SB(b, h) + boff + n * 2048 + k * 1024); } while (0)
#define PG8_MMA(ai, bj, At, Bt) do { __builtin_amdgcn_s_setprio(1); _Pragma("unroll") for (int m = 0; m < 4; ++m) _Pragma("unroll") for (int n = 0; n < 2; ++n) _Pragma("unroll") for (int k = 0; k < 2; ++k) \
        acc[ai][bj][m][n] = __builtin_amdgcn_mfma_f32_16x16x32_bf16(Bt[n][k], At[m][k], acc[ai][bj][m][n], 0, 0, 0); __builtin_amdgcn_s_setprio(0); } while (0)
#define PG8_WAIT_V(n) asm volatile("s_waitcnt vmcnt(" #n ")" ::: "memory")
#define PG8_WAIT_L(n) asm volatile("s_waitcnt lgkmcnt(" #n ")" ::: "memory")
#define PG8_BAR __builtin_amdgcn_s_barrier()
#define PG8_SCHED __builtin_amdgcn_sched_barrier(0)
    Unit cur, nxt; int ui = 0;
    if (!S.next(0, cur)) return;
    f32x4 acc[2][2][4][2];
#pragma unroll
    for (int a = 0; a < 2; ++a)
#pragma unroll
        for (int b = 0; b < 2; ++b)
#pragma unroll
            for (int m = 0; m < 4; ++m)
#pragma unroll
                for (int n = 0; n < 2; ++n) acc[a][b][m][n] = (f32x4){0.f, 0.f, 0.f, 0.f};
    bf16x8 At[4][2], B0[2][2], B1[2][2];
    const char* cA = (const char*)g.A + (size_t)cur.pm * tstepA; const char* cB = (const char*)g.Bt + (size_t)cur.pn * tstepB;
    S.a_ready(cur, ui);
    if constexpr (SP2) {
        PG8_STAGE(PG8_SB(0, 0), cB, voffB); PG8_STAGE(PG8_SB(0, 1), cB + hstepB, voffB); PG8_STAGE(PG8_SA(0, 0), cA, voffA); PG8_STAGE(PG8_SA(0, 1), cA + hstepA, voffA);
        if (wr == 1) PG8_BAR;
        PG8_WAIT_V(2); PG8_BAR;
        PG8_STAGE(PG8_SB(1, 0), cB + kstep, voffB); PG8_STAGE(PG8_SA(1, 0), cA + kstep, voffA); PG8_STAGE(PG8_SB(1, 1), cB + hstepB + kstep, voffB);
        PG8_WAIT_V(6); PG8_BAR;
    } else {
        PG8_STAGE(PG8_SB(0, 0), cB, voffB); PG8_STAGE(PG8_SA(0, 0), cA, voffA); PG8_STAGE(PG8_SB(0, 1), cB + hstepB, voffB); PG8_STAGE(PG8_SA(0, 1), cA + hstepA, voffA);
        if (wr == 1) PG8_BAR;
        PG8_WAIT_V(4); PG8_BAR;
        PG8_STAGE(PG8_SB(1, 0), cB + kstep, voffB); PG8_STAGE(PG8_SA(1, 0), cA + kstep, voffA); PG8_STAGE(PG8_SB(1, 1), cB + hstepB + kstep, voffB);
        PG8_WAIT_V(6); PG8_BAR;
    }
    for (;;) {
        const bool has_next = S.next(ui + 1, nxt);
        const char* nA = has_next ? (const char*)g.A + (size_t)nxt.pm * tstepA : cA; const char* nB = has_next ? (const char*)g.Bt + (size_t)nxt.pn * tstepB : cB;
        for (int t = 0; t < nt; t += 2) {
            const bool last = (t == nt - 2);
            const char* a1 = cA + (size_t)(t + 1) * kstep;
            const char* a2 = last ? nA : cA + (size_t)(t + 2) * kstep; const char* b2 = last ? nB : cB + (size_t)(t + 2) * kstep;
            const char* a3 = a2 + kstep; const char* b3 = b2 + kstep;
            if (last && has_next) S.a_ready(nxt, ui + 1);
            if constexpr (SP2) {
            PG8_LDB(B0, 0, 0); PG8_LDB(B1, 0, 1); PG8_SCHED; PG8_LDA(At, 0, 0); PG8_STAGE(PG8_SA(1, 1), a1 + hstepA, voffA);
            PG8_WAIT_V(8); PG8_WAIT_L(0); PG8_BAR; PG8_MMA(0, 0, At, B0); PG8_MMA(0, 1, At, B1); PG8_BAR; PG8_SCHED;
            PG8_LDA(At, 0, 1); PG8_STAGE(PG8_SB(0, 0), b2, voffB); PG8_STAGE(PG8_SB(0, 1), b2 + hstepB, voffB); PG8_STAGE(PG8_SA(0, 0), a2, voffA);
            PG8_WAIT_V(8); PG8_WAIT_L(0); PG8_BAR; PG8_MMA(1, 0, At, B0); PG8_MMA(1, 1, At, B1); PG8_BAR; PG8_SCHED;
            PG8_LDB(B0, 1, 0); PG8_LDB(B1, 1, 1); PG8_SCHED; PG8_LDA(At, 1, 0); PG8_STAGE(PG8_SA(0, 1), a2 + hstepA, voffA);
            PG8_WAIT_V(8); PG8_WAIT_L(0); PG8_BAR; PG8_MMA(0, 0, At, B0); PG8_MMA(0, 1, At, B1); PG8_BAR; PG8_SCHED;
            PG8_LDA(At, 1, 1); PG8_STAGE(PG8_SB(1, 0), b3, voffB); PG8_STAGE(PG8_SB(1, 1), b3 + hstepB, voffB); PG8_STAGE(PG8_SA(1, 0), a3, voffA);
            PG8_WAIT_V(8); PG8_WAIT_L(0); PG8_BAR; PG8_MMA(1, 0, At, B0); PG8_MMA(1, 1, At, B1); PG8_BAR; PG8_SCHED;
            } else {
            PG8_LDB(B0, 0, 0); PG8_SCHED; PG8_LDA(At, 0, 0); PG8_STAGE(PG8_SA(1, 1), a1 + hstepA, voffA);
            PG8_WAIT_L(8); PG8_BAR; PG8_WAIT_L(0); PG8_MMA(0, 0, At, B0); PG8_BAR; PG8_SCHED;
            PG8_LDB(B1, 0, 1); PG8_STAGE(PG8_SB(0, 0), b2, voffB);
            PG8_BAR; PG8_WAIT_L(0); PG8_MMA(0, 1, At, B1); PG8_BAR;
            PG8_LDA(At, 0, 1); PG8_STAGE(PG8_SA(0, 0), a2, voffA);
            PG8_BAR; PG8_WAIT_L(0); PG8_MMA(1, 0, At, B0); PG8_BAR; PG8_SCHED;
            PG8_STAGE(PG8_SB(0, 1), b2 + hstepB, voffB);
            PG8_WAIT_V(6); PG8_BAR; PG8_MMA(1, 1, At, B1); PG8_BAR;
            PG8_LDB(B0, 1, 0); PG8_SCHED; PG8_LDA(At, 1, 0); PG8_STAGE(PG8_SA(0, 1), a2 + hstepA, voffA);
            PG8_WAIT_L(8); PG8_BAR; PG8_WAIT_L(0); PG8_MMA(0, 0, At, B0); PG8_BAR; PG8_SCHED;
            PG8_LDB(B1, 1, 1); PG8_STAGE(PG8_SB(1, 0), b3, voffB);
            PG8_BAR; PG8_WAIT_L(0); PG8_MMA(0, 1, At, B1); PG8_BAR;
            PG8_LDA(At, 1, 1); PG8_STAGE(PG8_SA(1, 0), a3, voffA);
            PG8_BAR; PG8_WAIT_L(0); PG8_MMA(1, 0, At, B0); PG8_BAR; PG8_SCHED;
            PG8_STAGE(PG8_SB(1, 1), b3 + hstepB, voffB);
            PG8_WAIT_V(6); PG8_BAR; PG8_MMA(1, 1, At, B1); PG8_BAR;
            }
        }
        if constexpr (ALIGN_EPI) { if (wr == 0) PG8_BAR; }
        if constexpr (!Epi::AFTER_DRAIN) { E(acc, cur, wr, wc, fr, fq, ui); S.done(cur); }
        if (!has_next) break;
#pragma unroll
        for (int a = 0; a < 2; ++a)
#pragma unroll
            for (int b = 0; b < 2; ++b)
#pragma unroll
                for (int m = 0; m < 4; ++m)
#pragma unroll
                    for (int n = 0; n < 2; ++n) acc[a][b][m][n] = (f32x4){0.f, 0.f, 0.f, 0.f};
        cur = nxt; cA = nA; cB = nB; ++ui;
        if constexpr (ALIGN_EPI) { if (wr == 1) PG8_BAR; }
    }
    PG8_WAIT_V(0);
    if constexpr (!ALIGN_EPI) { if (wr == 0) PG8_BAR; }
    PG8_BAR;
    if constexpr (Epi::AFTER_DRAIN) { E.fused(acc, cur, wr, wc, fr, fq, lds, wid, lane); S.done(cur); }
#undef PG8_SA
#undef PG8_SB
#undef PG8_STAGE
#undef PG8_LDA
#undef PG8_LDB
#undef PG8_MMA
#undef PG8_WAIT_V
#undef PG8_WAIT_L
#undef PG8_BAR
#undef PG8_SCHED
}
}
namespace pg8 {
__device__ __forceinline__ unsigned cvt_pk_bf16(float lo, float hi) { unsigned r; asm volatile("v_cvt_pk_bf16_f32 %0, %1, %2" : "=v"(r) : "v"(lo), "v"(hi)); return r; }

constexpr int RS_LDS_OFF = STAGE_BYTES, RS_LDS_BUF = 8192;
struct OrderRS : StaticOrder {
    const float* rs_ssq; int rs_nslot; PG8_LAS unsigned char* lds;
    __device__ __forceinline__ void a_ready(const Unit& u, int ui) const {
        const int wid = __builtin_amdgcn_readfirstlane(threadIdx.x >> 6), lane = threadIdx.x & 63;
        for (int i = wid; i < rs_nslot * 4; i += 8) { const int slot = i >> 2, rb = i & 3;
            __builtin_amdgcn_global_load_lds((const unsigned*)(rs_ssq + (size_t)slot * T + u.pm * BM + rb * 64 + lane),
                                             (PG8_LAS unsigned*)(lds + RS_LDS_OFF + (ui & 1) * RS_LDS_BUF + slot * 1024 + rb * 256), 4, 0, 0); }
    }
};
struct EpiBf16RS {
    static constexpr bool PERM = true, AFTER_DRAIN = false;
    bf16_t* O; int ldc;
    const float* rs_ssq; int rs_nslot; float rs_invn;
    int skip;
    float* ssq_out; int ssq_mode;
    PG8_LAS unsigned char* lds;
    bf16_t* O2; int split_pn;
    __device__ __forceinline__ void operator()(const f32x4 (&acc)[2][2][4][2], const Unit& u, int wr, int wc, int fr, int fq, int ui) const {
        if (skip == 1) return;
        const int row0 = u.pm * BM + wr * 64 + fr, col0 = u.pn * BM + wc * 32 + 8 * fq;
        float scs[2][4];
#pragma unroll
        for (int ai = 0; ai < 2; ++ai)
#pragma unroll
            for (int m = 0; m < 4; ++m) { float s = 0.f;
                if (rs_nslot && skip != 3) { const PG8_LAS float* rp = (const PG8_LAS float*)(lds + RS_LDS_OFF + (ui & 1) * RS_LDS_BUF) + wr * 64 + fr + ai * HALF + m * 16;
#pragma unroll
                    for (int i = 0; i < 8; ++i) if (i < rs_nslot) s += rp[i * 256]; }
                scs[ai][m] = s; }
#pragma unroll
        for (int ai = 0; ai < 2; ++ai)
#pragma unroll
            for (int m = 0; m < 4; ++m) {
                const int row = row0 + ai * HALF + m * 16;
                const float sc = rs_nslot ? rsqrtf(scs[ai][m] * rs_invn + EPS) : 1.f;
                bf16_t* rowp = (split_pn > 0 && u.pn >= split_pn) ? O2 + (size_t)row * ldc + (col0 - split_pn * BM) : O + (size_t)row * ldc + col0;
#pragma unroll
                for (int bj = 0; bj < 2; ++bj) {
                    const f32x4 v0 = acc[ai][bj][m][0] * sc, v1 = acc[ai][bj][m][1] * sc;
                    u32x4 w; w.x = cvt_pk_bf16(v0[0], v0[1]); w.y = cvt_pk_bf16(v0[2], v0[3]); w.z = cvt_pk_bf16(v1[0], v1[1]); w.w = cvt_pk_bf16(v1[2], v1[3]);
                    if (skip != 2) *(u32x4*)(rowp + bj * HALF) = w; else asm volatile("" :: "v"(w));
                    const bool do_ssq = ssq_mode == 2 ? (bj == 0) : (ssq_mode == 1 && 8 * u.pn + 4 * bj + wc < 22);
                    if (do_ssq) {
                        float q = (v0[0] * v0[0] + v0[1] * v0[1]) + (v0[2] * v0[2] + v0[3] * v0[3]) + (v1[0] * v1[0] + v1[1] * v1[1]) + (v1[2] * v1[2] + v1[3] * v1[3]);
                        q = sum_xor32(sum_xor16(q));
                        if (fq == 0) {
                            if (ssq_mode == 1) ssq_out[(size_t)(8 * u.pn + 4 * bj + wc) * T + row] = q;
                            else ssq_out[(size_t)(u.pn * 4 + wc) * T + row] = q;
                        }
                    }
                }
            }
    }
};

struct EpiResid {
    static constexpr bool PERM = false, AFTER_DRAIN = true;
    const float* xf; bf16_t* xb; float* outf; float* ssqx; int dry;
    __device__ __forceinline__ void fused(f32x4 (&acc)[2][2][4][2], const Unit& u, int wr, int wc, int fr, int fq, PG8_LAS unsigned char* lds, int wid, int lane) const {
        typedef unsigned u32x2v __attribute__((ext_vector_type(2)));
        PG8_LAS float* P = (PG8_LAS float*)lds;
        const int col0 = u.pn * BM + wc * 32 + 4 * fq;
#pragma unroll
        for (int ai = 0; ai < 2; ++ai) {
            f32x4 res[4][2][2];
#pragma unroll
            for (int m = 0; m < 4; ++m) { const size_t rowoff = (size_t)(u.pm * BM + ai * HALF + wr * 64 + m * 16 + fr) * DM + col0;
#pragma unroll
                for (int bj = 0; bj < 2; ++bj)
#pragma unroll
                    for (int n = 0; n < 2; ++n) { const size_t off = rowoff + bj * HALF + n * 16;
                        if (xf) res[m][bj][n] = *(const f32x4*)(xf + off);
                        else { const u32x2v w = *(const u32x2v*)(xb + off); res[m][bj][n] = (f32x4){__uint_as_float(w.x << 16), __uint_as_float(w.x & 0xffff0000u), __uint_as_float(w.y << 16), __uint_as_float(w.y & 0xffff0000u)}; } } }
#pragma unroll
            for (int m = 0; m < 4; ++m) {
                const int r = ai * HALF + wr * 64 + m * 16 + fr; const size_t rowoff = (size_t)(u.pm * BM + r) * DM + col0; float q = 0.f;
#pragma unroll
                for (int bj = 0; bj < 2; ++bj)
#pragma unroll
                    for (int n = 0; n < 2; ++n) {
                        const size_t off = rowoff + bj * HALF + n * 16;
                        const f32x4 v = res[m][bj][n] + acc[ai][bj][m][n];
                        if (dry) { q += v[0]; } else if (outf) *(f32x4*)(outf + off) = v;
                        else { u32x2v w; w.x = cvt_pk_bf16(v[0], v[1]); w.y = cvt_pk_bf16(v[2], v[3]); *(u32x2v*)(xb + off) = w;
                               const float a = __uint_as_float(w.x << 16), b = __uint_as_float(w.x & 0xffff0000u), c = __uint_as_float(w.y << 16), d = __uint_as_float(w.y & 0xffff0000u);
                               q += (a * a + b * b) + (c * c + d * d); }
                    }
                if (!outf) { q = sum_xor32(sum_xor16(q)); if (fq == 0) P[r * 4 + wc] = q; }
            }
        }
        if (!outf && !dry) {
            __syncthreads();
            const int t = wid * 64 + lane;
            if (t < 256) ssqx[(size_t)u.pn * T + u.pm * BM + t] = (P[t * 4 + 0] + P[t * 4 + 1]) + (P[t * 4 + 2] + P[t * 4 + 3]);
        }
    }
};
}
constexpr int NWAVES = 8;
constexpr int GRID = 256;
constexpr int LDS_BYTES = 163840;
constexpr int LDSCTL_OFF = 0, MISC_OFF = 320;
constexpr int RING_OFF = 512, RING_BYTES = LDS_BYTES - RING_OFF;
constexpr int CW_BAR = 4096;
constexpr int N_PHASES = 17;

enum PhaseKind { K_PROLOGUE = 0, K_MLA_G1, K_MLA_G2, K_MLA_ATT, K_OUT, K_NSA_G1, K_NSA_POST, K_NSA_ATT };
struct PhaseDesc { int kind, j, half, L; };
__host__ __device__ inline PhaseDesc decode_phase(int ph) {
    PhaseDesc d{K_PROLOGUE, 0, 0, 0}; if (ph == 0) return d;
    const int p = ph - 1; d.j = p / 8; const int r = p % 8;
    if (r < 4) { d.L = 2 * d.j; d.kind = r == 0 ? K_MLA_G1 : r == 1 ? K_MLA_G2 : r == 2 ? K_MLA_ATT : K_OUT; }
    else { d.L = 2 * d.j + 1; const int q = r - 4; d.kind = q == 0 ? K_NSA_G1 : q == 1 ? K_NSA_POST : q == 2 ? K_NSA_ATT : K_OUT; }
    return d;
}

struct Args { const void* in[N_INPUTS]; float* out; unsigned char* ws; int ph_lo, ph_hi, dry, pad; };

struct Frame {
    LAS unsigned char* lds; int tid, lane, wave, G;
    const void* const* in; float* out; unsigned char* ws;
    __device__ __forceinline__ const float* f(int i) const { return (const float*)in[i]; }
    __device__ __forceinline__ bf16_t* xb() const { return (bf16_t*)(ws + WS_XB); }
    __device__ __forceinline__ bf16_t* p1() const { return (bf16_t*)(ws + WS_P1); }
    __device__ __forceinline__ bf16_t* kvh() const { return (bf16_t*)(ws + WS_KVH); }
    __device__ __forceinline__ bf16_t* kvh2() const { return (bf16_t*)out; }
    __device__ __forceinline__ bf16_t* kpes() const { return (bf16_t*)(ws + WS_KPES); }
    __device__ __forceinline__ bf16_t* kcmp() const { return (bf16_t*)(ws + WS_KCMP); }
    __device__ __forceinline__ bf16_t* vcmp() const { return (bf16_t*)(ws + WS_VCMP); }
    __device__ __forceinline__ float* ssqx() const { return (float*)(ws + WS_SSQX); }
    __device__ __forceinline__ float* ssq1() const { return (float*)(ws + WS_SSQ1); }
    __device__ __forceinline__ float* ssqkn() const { return (float*)(ws + WS_SSQKN); }
    __device__ __forceinline__ float* cosM() const { return (float*)(ws + WS_COSM); }
    __device__ __forceinline__ float* sinM() const { return (float*)(ws + WS_SINM); }
    __device__ __forceinline__ float* cosN() const { return (float*)(ws + WS_COSN); }
    __device__ __forceinline__ float* sinN() const { return (float*)(ws + WS_SINN); }
};

__device__ __forceinline__ void phase_kpes(Frame& F, int j) {
    const bf16_t* p1 = F.p1(); const float* gk = F.f(I_MGK) + j * 192; const float* cosM = F.cosM(); const float* sinM = F.sinM(); bf16_t* kpes = F.kpes();
    constexpr int NTH = GRID * NWAVES * 64;
    float av[4], bv[4], cv[4], sv[4];
#pragma unroll
    for (int u = 0; u < 4; ++u) { const int i = blockIdx.x * (NWAVES * 64) + F.tid + u * NTH; const int t = i >> 5, f = i & 31;
        av[u] = bf2f(p1[(size_t)t * M_INP + M_KPE + f]) * gk[f]; bv[u] = bf2f(p1[(size_t)t * M_INP + M_KPE + 32 + f]) * gk[32 + f]; cv[u] = cosM[i]; sv[u] = sinM[i]; }
#pragma unroll
    for (int u = 0; u < 4; ++u) { const int i = blockIdx.x * (NWAVES * 64) + F.tid + u * NTH; const int t = i >> 5, f = i & 31;
        kpes[(size_t)t * 64 + f] = f2bf(av[u] * cv[u] - bv[u] * sv[u]); kpes[(size_t)t * 64 + 32 + f] = f2bf(bv[u] * cv[u] + av[u] * sv[u]); }
}
namespace pro {
__device__ __forceinline__ void sincos_rev(float ang, float& s, float& c) {
    double r = (double)ang * 0.15915494309189535; r -= floor(r);
    const float fr = (float)r; s = __builtin_amdgcn_sinf(fr); c = __builtin_amdgcn_cosf(fr);
}
__device__ __forceinline__ void transpose_item(const float* __restrict__ W, const float* __restrict__ g, bf16_t* __restrict__ WT, int K, int N, int Npad, LAS float* scr, int item, int lane) {
    const int nblk = Npad / 32, kb = item / nblk, nb = item - kb * nblk, k0 = 64 * kb, n0 = 32 * nb;
    float v[32];
#pragma unroll
    for (int i = 0; i < 32; ++i) { const int k = k0 + 2 * i + (lane >> 5), n = n0 + (lane & 31); v[i] = (k < K && n < N) ? W[(size_t)k * N + n] : 0.f; }
    if (g) {
#pragma unroll
        for (int i = 0; i < 32; ++i) { const int k = k0 + 2 * i + (lane >> 5); v[i] *= (k < K) ? g[k] : 0.f; } }
#pragma unroll
    for (int i = 0; i < 32; ++i) scr[(2 * i + (lane >> 5)) * 33 + (lane & 31)] = v[i];
    LDS_WAIT(); asm volatile("" ::: "memory");
    const int c = lane & 7;
    if (k0 + 8 * c < K) {
#pragma unroll
        for (int jj = 0; jj < 4; ++jj) { const int n = (lane >> 3) + 8 * jj; const LAS float* s = scr + (8 * c) * 33 + n;
            v4u o; o.x = pk2(s[0 * 33], s[1 * 33]); o.y = pk2(s[2 * 33], s[3 * 33]); o.z = pk2(s[4 * 33], s[5 * 33]); o.w = pk2(s[6 * 33], s[7 * 33]);
            *(v4u*)(WT + (size_t)(n0 + n) * K + k0 + 8 * c) = o; } }
    LDS_WAIT(); asm volatile("" ::: "memory");
}
struct TDesc { const float* W; const float* g; bf16_t* WT; int K, N, Npad; };
__device__ __forceinline__ TDesc tdesc(Frame& F, int m) {
    const int j = m / 10, i = m % 10; const MlaW mw = mla_w(F.ws, j); const NsaW nw = nsa_w(F.ws, j);
    switch (i) {
    case 0: return TDesc{F.f(I_MWIN) + (size_t)j * 1024 * M_IN, F.f(I_NORMG) + (2 * j) * DM, mw.win, 1024, M_IN, M_INP};
    case 1: return TDesc{F.f(I_MWUQ) + (size_t)j * 384 * 3072, F.f(I_MGCQ) + j * 384, mw.wuq, 384, 3072, 3072};
    case 2: return TDesc{F.f(I_MWUKV) + (size_t)j * 256 * 4096, F.f(I_MGCKV) + j * 256, mw.wukv, 256, 4096, 4096};
    case 3: return TDesc{F.f(I_MWOUT) + (size_t)j * 2048 * 1024, nullptr, mw.wout, 2048, 1024, 1024};
    case 4: return TDesc{F.f(I_NWIN) + (size_t)j * 1024 * N_IN, F.f(I_NORMG) + (2 * j + 1) * DM, nw.win, 1024, N_IN, N_INP};
    case 5: return TDesc{F.f(I_NW1K) + (size_t)j * 3072 * 96, nullptr, nw.w1k, 3072, 96, 96};
    case 6: return TDesc{F.f(I_NW2K) + (size_t)j * 96 * 96, nullptr, nw.w2k, 96, 96, 96};
    case 7: return TDesc{F.f(I_NW1V) + (size_t)j * 2048 * 64, nullptr, nw.w1v, 2048, 64, 64};
    case 8: return TDesc{F.f(I_NW2V) + (size_t)j * 64 * 64, nullptr, nw.w2v, 64, 64, 64};
    default: return TDesc{F.f(I_NWOUT) + (size_t)j * 1024 * 1024, nullptr, nw.wout, 1024, 1024, 1024};
    }
}
__device__ __forceinline__ void phase_prologue(Frame& F) {
    const int tid = F.tid, lane = tid & 63, wid = __builtin_amdgcn_readfirstlane(tid >> 6);
    const int gw = blockIdx.x * NWAVES + wid, NGW = GRID * NWAVES;
    LAS float* scr = (LAS float*)(F.lds + RING_OFF + wid * 16384);
    { const float* x = F.f(I_X); bf16_t* xb = F.xb(); float* ssqx = F.ssqx();
      for (int m0 = 2 * gw; m0 < T; m0 += 2 * NGW) { f32x4 v[2][4];
#pragma unroll
          for (int rr = 0; rr < 2; ++rr)
#pragma unroll
              for (int jj = 0; jj < 4; ++jj) v[rr][jj] = ((const f32x4*)(x + (size_t)(m0 + rr) * DM) + lane)[64 * jj];
#pragma unroll
          for (int rr = 0; rr < 2; ++rr) { const int m = m0 + rr; unsigned long long* o8 = (unsigned long long*)(xb + (size_t)m * DM) + lane; float s = 0.f;
#pragma unroll
              for (int jj = 0; jj < 4; ++jj) { const f32x4 w = v[rr][jj]; const unsigned lo = pk2(w.x, w.y), hi2 = pk2(w.z, w.w); o8[64 * jj] = (unsigned long long)lo | ((unsigned long long)hi2 << 32);
                  const float a = __uint_as_float(lo << 16), b = __uint_as_float(lo & 0xffff0000u), c = __uint_as_float(hi2 << 16), d = __uint_as_float(hi2 & 0xffff0000u); s += (a * a + b * b) + (c * c + d * d); }
              s = wave_sum(s);
              if (lane == 0) { ssqx[m] = s; ssqx[T + m] = 0.f; ssqx[2 * T + m] = 0.f; ssqx[3 * T + m] = 0.f; } } } }
    for (int m = 0; m < 20; ++m) { const TDesc d = tdesc(F, m); const int items = ((d.K + 63) / 64) * (d.Npad / 32);
        for (int it = gw; it < items; it += NGW) transpose_item(d.W, d.g, d.WT, d.K, d.N, d.Npad, scr, it, lane); }
    { const int* pos = (const int*)F.in[I_POS]; float* cM = F.cosM(); float* sM = F.sinM(); float* cN = F.cosN(); float* sN = F.sinN();
      for (int i = blockIdx.x * (NWAVES * 64) + tid; i < T * 32; i += GRID * NWAVES * 64) { const int t = i >> 5, f = i & 31; float s, c; sincos_rev((float)pos[t] * c_invf32[f], s, c); cM[i] = c; sM[i] = s; }
      for (int i = blockIdx.x * (NWAVES * 64) + tid; i < T * 12; i += GRID * NWAVES * 64) { const int t = i / 12, f = i - t * 12; float s, c; sincos_rev((float)pos[t] * c_invf12[f], s, c); cN[i] = c; sN[i] = s; } }
}
}
namespace att {
typedef short bf16x8 __attribute__((ext_vector_type(8)));
typedef short s16x4 __attribute__((ext_vector_type(4)));
typedef float f32x16 __attribute__((ext_vector_type(16)));
typedef float f32x4 __attribute__((ext_vector_type(4)));
typedef unsigned u32x4 __attribute__((ext_vector_type(4)));
#define SBAR() __builtin_amdgcn_sched_barrier(0)
__device__ __forceinline__ int crow(int r, int hi) { return (r & 3) + 8 * (r >> 2) + 4 * hi; }
__device__ __forceinline__ unsigned cvtpk(float lo, float hi) { unsigned r; asm volatile("v_cvt_pk_bf16_f32 %0, %1, %2" : "=v"(r) : "v"(lo), "v"(hi)); return r; }
__device__ __forceinline__ bf16x8 pack8(f32x4 a, f32x4 b) { u32x4 w = {cvtpk(a[0], a[1]), cvtpk(a[2], a[3]), cvtpk(b[0], b[1]), cvtpk(b[2], b[3])}; return __builtin_bit_cast(bf16x8, w); }
__device__ __forceinline__ void unpack8(u32x4 w, float* f) {
    f[0] = __uint_as_float(w.x << 16); f[1] = __uint_as_float(w.x & 0xffff0000u); f[2] = __uint_as_float(w.y << 16); f[3] = __uint_as_float(w.y & 0xffff0000u);
    f[4] = __uint_as_float(w.z << 16); f[5] = __uint_as_float(w.z & 0xffff0000u); f[6] = __uint_as_float(w.w << 16); f[7] = __uint_as_float(w.w & 0xffff0000u);
}
template <int NB32> __device__ __forceinline__ int v_st(int k, int c) { const int kk = (k & ~0xC) | ((k & 4) << 1) | ((k & 8) >> 1); return ((kk >> 3) * NB32 + (c >> 5)) * 512 + ((kk & 7) * 32 + (c & 31)) * 2; }
__device__ __forceinline__ int v_rd_base(int lane) { return ((lane & 3) << 3) | (((lane >> 2) & 3) << 6) | (((lane >> 4) & 1) << 5) | (((lane >> 5) & 1) << 8); }
__device__ __forceinline__ void softmax_tile(f32x16& p0, f32x16& p1, float& m_reg, float& l_reg, float& alpha, bf16x8& pa0, bf16x8& pa1, bf16x8& pa2, bf16x8& pa3) {
    float pmax = p0[0];
#pragma unroll
    for (int r = 1; r < 16; ++r) pmax = fmaxf(pmax, p0[r]);
#pragma unroll
    for (int r = 0; r < 16; ++r) pmax = fmaxf(pmax, p1[r]);
    { auto rr = __builtin_amdgcn_permlane32_swap(__float_as_uint(pmax), __float_as_uint(pmax), false, false); pmax = fmaxf(__uint_as_float(rr[0]), __uint_as_float(rr[1])); }
    const float mn = fmaxf(m_reg, pmax);
    alpha = __builtin_amdgcn_exp2f(m_reg - mn); m_reg = mn;
    float ps = 0.f;
#pragma unroll
    for (int r = 0; r < 16; ++r) { p0[r] = __builtin_amdgcn_exp2f(p0[r] - mn); ps += p0[r]; }
#pragma unroll
    for (int r = 0; r < 16; ++r) { p1[r] = __builtin_amdgcn_exp2f(p1[r] - mn); ps += p1[r]; }
    { auto rr = __builtin_amdgcn_permlane32_swap(__float_as_uint(ps), __float_as_uint(ps), false, false); ps = __uint_as_float(rr[0]) + __uint_as_float(rr[1]); }
    l_reg = l_reg * alpha + ps;
#define ATT_PK4(P, B_, OUT) do { unsigned a0 = cvtpk(P[B_ + 0], P[B_ + 1]), a1 = cvtpk(P[B_ + 2], P[B_ + 3]); unsigned b0 = cvtpk(P[B_ + 4], P[B_ + 5]), b1 = cvtpk(P[B_ + 6], P[B_ + 7]); \
        auto r0 = __builtin_amdgcn_permlane32_swap(a0, b0, false, false); auto r1 = __builtin_amdgcn_permlane32_swap(a1, b1, false, false); \
        u32x4 w = {r0[0], r1[0], r0[1], r1[1]}; OUT = __builtin_bit_cast(bf16x8, w); } while (0)
    ATT_PK4(p0, 0, pa0); ATT_PK4(p0, 8, pa1); ATT_PK4(p1, 0, pa2); ATT_PK4(p1, 8, pa3);
}
template <int NB32, int VOFF> __device__ __forceinline__ void pv_tile(f32x16* o, int vb, bf16x8 pa0, bf16x8 pa1, bf16x8 pa2, bf16x8 pa3) {
#define TRRD(dst, off) asm volatile("ds_read_b64_tr_b16 %0, %1 offset:%2" : "=&v"(dst) : "v"(vb), "i"(off) : "memory")
#pragma unroll
    for (int d0 = 0; d0 < NB32; ++d0) {
        s16x4 l0, l1, l2, l3, h0, h1, h2, h3; constexpr int KS = NB32 * 1024, HF = NB32 * 512;
#define TRR(dst, ks, hf) do { if (d0 == 0) TRRD(dst, VOFF + 0 * 512 + (ks) * KS + (hf) * HF); else if (d0 == 1) TRRD(dst, VOFF + 1 * 512 + (ks) * KS + (hf) * HF); \
                              else if (d0 == 2) TRRD(dst, VOFF + 2 * 512 + (ks) * KS + (hf) * HF); else TRRD(dst, VOFF + 3 * 512 + (ks) * KS + (hf) * HF); } while (0)
        TRR(l0, 0, 0); TRR(h0, 0, 1); TRR(l1, 1, 0); TRR(h1, 1, 1); TRR(l2, 2, 0); TRR(h2, 2, 1); TRR(l3, 3, 0); TRR(h3, 3, 1);
        asm volatile("s_waitcnt lgkmcnt(0)" ::: "memory"); SBAR();
        o[d0] = __builtin_amdgcn_mfma_f32_32x32x16_bf16(pa0, (bf16x8){l0[0], l0[1], l0[2], l0[3], h0[0], h0[1], h0[2], h0[3]}, o[d0], 0, 0, 0);
        o[d0] = __builtin_amdgcn_mfma_f32_32x32x16_bf16(pa1, (bf16x8){l1[0], l1[1], l1[2], l1[3], h1[0], h1[1], h1[2], h1[3]}, o[d0], 0, 0, 0);
        o[d0] = __builtin_amdgcn_mfma_f32_32x32x16_bf16(pa2, (bf16x8){l2[0], l2[1], l2[2], l2[3], h2[0], h2[1], h2[2], h2[3]}, o[d0], 0, 0, 0);
        o[d0] = __builtin_amdgcn_mfma_f32_32x32x16_bf16(pa3, (bf16x8){l3[0], l3[1], l3[2], l3[3], h3[0], h3[1], h3[2], h3[3]}, o[d0], 0, 0, 0);
#undef TRR
    }
#undef TRRD
}
constexpr float THR2 = 5.f;
__device__ __forceinline__ float max3f(float a, float b, float c) { return __builtin_fmaxf(__builtin_fmaxf(a, b), c); }
__device__ __forceinline__ void softmax_sub(f32x16& p, float& m_reg, float& l_reg, float& alpha, bool& resc, bf16x8& pa0, bf16x8& pa1) {
    float pa_ = max3f(p[0], p[1], p[2]), pb_ = max3f(p[3], p[4], p[5]);
    pa_ = max3f(pa_, p[6], p[7]); pb_ = max3f(pb_, p[8], p[9]); pa_ = max3f(pa_, p[10], p[11]); pb_ = max3f(pb_, p[12], p[13]); pa_ = max3f(pa_, p[14], p[15]);
    float pmax = __builtin_fmaxf(pa_, pb_);
    { auto rr = __builtin_amdgcn_permlane32_swap(__float_as_uint(pmax), __float_as_uint(pmax), false, false); pmax = __builtin_fmaxf(__uint_as_float(rr[0]), __uint_as_float(rr[1])); }
    resc = !__all(pmax - m_reg <= THR2);
    alpha = 1.f;
    if (resc) { const float mn = __builtin_fmaxf(m_reg, pmax); alpha = __builtin_amdgcn_exp2f(m_reg - mn); m_reg = mn; l_reg *= alpha; }
    const float mn2 = m_reg;
    float ps = 0.f;
#pragma unroll
    for (int r = 0; r < 16; ++r) { p[r] = __builtin_amdgcn_exp2f(p[r] - mn2); ps += p[r]; }
    { auto rr = __builtin_amdgcn_permlane32_swap(__float_as_uint(ps), __float_as_uint(ps), false, false); ps = __uint_as_float(rr[0]) + __uint_as_float(rr[1]); }
    l_reg += ps;
    ATT_PK4(p, 0, pa0); ATT_PK4(p, 8, pa1);
}
typedef float f32x2 __attribute__((ext_vector_type(2)));
__device__ __forceinline__ void softmax_sub_off(f32x16& p, float c0, float& m_reg, float& l_reg, float& alpha, bool& resc, bf16x8& pa0, bf16x8& pa1) {
    float pa_ = max3f(p[0], p[1], p[2]), pb_ = max3f(p[3], p[4], p[5]);
    pa_ = max3f(pa_, p[6], p[7]); pb_ = max3f(pb_, p[8], p[9]); pa_ = max3f(pa_, p[10], p[11]); pb_ = max3f(pb_, p[12], p[13]); pa_ = max3f(pa_, p[14], p[15]);
    float pmax = __builtin_fmaxf(pa_, pb_);
    { auto rr = __builtin_amdgcn_permlane32_swap(__float_as_uint(pmax), __float_as_uint(pmax), false, false); pmax = __builtin_fmaxf(__uint_as_float(rr[0]), __uint_as_float(rr[1])); }
    resc = !__all((pmax + c0) - m_reg <= THR2);
    alpha = 1.f;
    if (resc) { const float mn = __builtin_fmaxf(m_reg, pmax + c0); alpha = __builtin_amdgcn_exp2f(m_reg - mn); m_reg = mn; l_reg *= alpha;
        const float sh = mn - c0;
#pragma unroll
        for (int r = 0; r < 16; ++r) p[r] -= sh; }
    f32x2 sa = {0.f, 0.f}, sb = {0.f, 0.f};
#pragma unroll
    for (int r = 0; r < 16; r += 4) { p[r] = __builtin_amdgcn_exp2f(p[r]); p[r + 1] = __builtin_amdgcn_exp2f(p[r + 1]); p[r + 2] = __builtin_amdgcn_exp2f(p[r + 2]); p[r + 3] = __builtin_amdgcn_exp2f(p[r + 3]);
        sa += (f32x2){p[r], p[r + 1]}; sb += (f32x2){p[r + 2], p[r + 3]}; }
    sa += sb; float ps = sa[0] + sa[1];
    { auto rr = __builtin_amdgcn_permlane32_swap(__float_as_uint(ps), __float_as_uint(ps), false, false); ps = __uint_as_float(rr[0]) + __uint_as_float(rr[1]); }
    l_reg += ps;
    ATT_PK4(p, 0, pa0); ATT_PK4(p, 8, pa1);
}
__device__ __forceinline__ void softmax64(f32x16& p0, f32x16& p1, float& m_reg, float& l_reg, float& alpha, bool& resc, bf16x8& pa0, bf16x8& pa1, bf16x8& pa2, bf16x8& pa3) {
    float xa = max3f(p0[0], p0[1], p0[2]), xb = max3f(p0[3], p0[4], p0[5]), xc = max3f(p1[0], p1[1], p1[2]), xd = max3f(p1[3], p1[4], p1[5]);
    xa = max3f(xa, p0[6], p0[7]); xb = max3f(xb, p0[8], p0[9]); xc = max3f(xc, p1[6], p1[7]); xd = max3f(xd, p1[8], p1[9]);
    xa = max3f(xa, p0[10], p0[11]); xb = max3f(xb, p0[12], p0[13]); xc = max3f(xc, p1[10], p1[11]); xd = max3f(xd, p1[12], p1[13]);
    xa = max3f(xa, p0[14], p0[15]); xc = max3f(xc, p1[14], p1[15]);
    float pmax = __builtin_fmaxf(__builtin_fmaxf(xa, xb), __builtin_fmaxf(xc, xd));
    { auto rr = __builtin_amdgcn_permlane32_swap(__float_as_uint(pmax), __float_as_uint(pmax), false, false); pmax = __builtin_fmaxf(__uint_as_float(rr[0]), __uint_as_float(rr[1])); }
    resc = !__all(pmax - m_reg <= THR2);
    alpha = 1.f;
    if (resc) { const float mn = __builtin_fmaxf(m_reg, pmax); alpha = __builtin_amdgcn_exp2f(m_reg - mn); m_reg = mn; l_reg *= alpha; }
    const float mn2 = m_reg;
    float s0 = 0.f, s1 = 0.f, s2 = 0.f, s3 = 0.f;
#pragma unroll
    for (int r = 0; r < 16; r += 2) { p0[r] = __builtin_amdgcn_exp2f(p0[r] - mn2); s0 += p0[r]; p0[r + 1] = __builtin_amdgcn_exp2f(p0[r + 1] - mn2); s1 += p0[r + 1]; }
#pragma unroll
    for (int r = 0; r < 16; r += 2) { p1[r] = __builtin_amdgcn_exp2f(p1[r] - mn2); s2 += p1[r]; p1[r + 1] = __builtin_amdgcn_exp2f(p1[r + 1] - mn2); s3 += p1[r + 1]; }
    float ps = (s0 + s1) + (s2 + s3);
    { auto rr = __builtin_amdgcn_permlane32_swap(__float_as_uint(ps), __float_as_uint(ps), false, false); ps = __uint_as_float(rr[0]) + __uint_as_float(rr[1]); }
    l_reg += ps;
    ATT_PK4(p0, 0, pa0); ATT_PK4(p0, 8, pa1); ATT_PK4(p1, 0, pa2); ATT_PK4(p1, 8, pa3);
}
__device__ __forceinline__ void softmax64_off(f32x16& p0, f32x16& p1, float c0, float& m_reg, float& l_reg, float& alpha, bool& resc, bf16x8& pa0, bf16x8& pa1, bf16x8& pa2, bf16x8& pa3) {
    float xa = max3f(p0[0], p0[1], p0[2]), xb = max3f(p0[3], p0[4], p0[5]), xc = max3f(p1[0], p1[1], p1[2]), xd = max3f(p1[3], p1[4], p1[5]);
    xa = max3f(xa, p0[6], p0[7]); xb = max3f(xb, p0[8], p0[9]); xc = max3f(xc, p1[6], p1[7]); xd = max3f(xd, p1[8], p1[9]);
    xa = max3f(xa, p0[10], p0[11]); xb = max3f(xb, p0[12], p0[13]); xc = max3f(xc, p1[10], p1[11]); xd = max3f(xd, p1[12], p1[13]);
    xa = max3f(xa, p0[14], p0[15]); xc = max3f(xc, p1[14], p1[15]);
    float pmax = __builtin_fmaxf(__builtin_fmaxf(xa, xb), __builtin_fmaxf(xc, xd));
    { auto rr = __builtin_amdgcn_permlane32_swap(__float_as_uint(pmax), __float_as_uint(pmax), false, false); pmax = __builtin_fmaxf(__uint_as_float(rr[0]), __uint_as_float(rr[1])); }
    resc = !__all((pmax + c0) - m_reg <= THR2);
    alpha = 1.f;
    if (resc) { const float mn = __builtin_fmaxf(m_reg, pmax + c0); alpha = __builtin_amdgcn_exp2f(m_reg - mn); m_reg = mn; l_reg *= alpha;
        const float sh = mn - c0;
#pragma unroll
        for (int r = 0; r < 16; ++r) { p0[r] -= sh; p1[r] -= sh; } }
    float s0 = 0.f, s1 = 0.f, s2 = 0.f, s3 = 0.f;
#pragma unroll
    for (int r = 0; r < 16; r += 2) { p0[r] = __builtin_amdgcn_exp2f(p0[r]); s0 += p0[r]; p0[r + 1] = __builtin_amdgcn_exp2f(p0[r + 1]); s1 += p0[r + 1]; }
#pragma unroll
    for (int r = 0; r < 16; r += 2) { p1[r] = __builtin_amdgcn_exp2f(p1[r]); s2 += p1[r]; p1[r + 1] = __builtin_amdgcn_exp2f(p1[r + 1]); s3 += p1[r + 1]; }
    float ps = (s0 + s1) + (s2 + s3);
    { auto rr = __builtin_amdgcn_permlane32_swap(__float_as_uint(ps), __float_as_uint(ps), false, false); ps = __uint_as_float(rr[0]) + __uint_as_float(rr[1]); }
    l_reg += ps;
    ATT_PK4(p0, 0, pa0); ATT_PK4(p0, 8, pa1); ATT_PK4(p1, 0, pa2); ATT_PK4(p1, 8, pa3);
}
template <int NB32> struct VFrag { s16x4 l0[NB32], h0[NB32], l1[NB32], h1[NB32]; };
template <int NB32, int VOFF> __device__ __forceinline__ void v_issue(VFrag<NB32>& f, int vb) {
#define TRRD(dst, off) asm volatile("ds_read_b64_tr_b16 %0, %1 offset:%2" : "=&v"(dst) : "v"(vb), "i"(off) : "memory")
    constexpr int KS = NB32 * 1024, HF = NB32 * 512;
#define VI_D0(D0) do { TRRD(f.l0[D0], VOFF + (D0) * 512); TRRD(f.h0[D0], VOFF + (D0) * 512 + HF); TRRD(f.l1[D0], VOFF + (D0) * 512 + KS); TRRD(f.h1[D0], VOFF + (D0) * 512 + KS + HF); } while (0)
    VI_D0(0); VI_D0(1); if constexpr (NB32 > 2) { VI_D0(2); VI_D0(3); }
#undef VI_D0
#undef TRRD
}
template <int NB32, bool SWAP = false> __device__ __forceinline__ void v_consume(f32x16* o, VFrag<NB32>& f, bf16x8 pa0, bf16x8 pa1) {
    asm volatile("s_waitcnt lgkmcnt(0)" : "+v"(f.l0[0]), "+v"(f.h0[0]), "+v"(f.l1[0]), "+v"(f.h1[0]), "+v"(f.l0[1]), "+v"(f.h0[1]), "+v"(f.l1[1]), "+v"(f.h1[1]) :: "memory");
    if constexpr (NB32 > 2) asm volatile("" : "+v"(f.l0[2]), "+v"(f.h0[2]), "+v"(f.l1[2]), "+v"(f.h1[2]), "+v"(f.l0[3]), "+v"(f.h0[3]), "+v"(f.l1[3]), "+v"(f.h1[3]));
    SBAR();
#pragma unroll
    for (int d0 = 0; d0 < NB32; ++d0) {
        const bf16x8 v0 = {f.l0[d0][0], f.l0[d0][1], f.l0[d0][2], f.l0[d0][3], f.h0[d0][0], f.h0[d0][1], f.h0[d0][2], f.h0[d0][3]};
        const bf16x8 v1 = {f.l1[d0][0], f.l1[d0][1], f.l1[d0][2], f.l1[d0][3], f.h1[d0][0], f.h1[d0][1], f.h1[d0][2], f.h1[d0][3]};
        if constexpr (SWAP) { o[d0] = __builtin_amdgcn_mfma_f32_32x32x16_bf16(v0, pa0, o[d0], 0, 0, 0); o[d0] = __builtin_amdgcn_mfma_f32_32x32x16_bf16(v1, pa1, o[d0], 0, 0, 0); }
        else { o[d0] = __builtin_amdgcn_mfma_f32_32x32x16_bf16(pa0, v0, o[d0], 0, 0, 0); o[d0] = __builtin_amdgcn_mfma_f32_32x32x16_bf16(pa1, v1, o[d0], 0, 0, 0); }
    }
}
}

#define MLA_VAR 0
#define NSA_VAR 0
namespace mla {
using namespace att;
constexpr int KP = 400, KT = 64 * KP, VT = 64 * 128 * 2;
constexpr int L_K = 0, L_V = 2 * KT, L_KS = L_V + 2 * VT, L_WS = L_KS + SEQ * 4, L_G = L_WS + NWAVES * 256, L_END = L_G + 2 * 192 * 4;
static_assert(L_END <= RING_BYTES, "MLA attention LDS");


__device__ __forceinline__ void attn_unit(Frame& F, int j, int b, int h, int qb, int dry, bool prestaged, int h_next) {
    int tid_ = F.tid; asm volatile("" : "+v"(tid_));
    const int tid = tid_, lane = tid & 63, wid = __builtin_amdgcn_readfirstlane(tid >> 6), r32 = lane & 31, hi = lane >> 5;
    const int hl = h & 7;
    const size_t rowbase = (size_t)b * SEQ; const int q0 = qb * 256;
    const bf16_t* kvh = h < 8 ? F.kvh() : F.kvh2(); const bf16_t* kpes = F.kpes(); bf16_t* pbuf = F.p1();
    const float* ssq1 = F.ssq1();
    LAS unsigned char* lds = F.lds + RING_OFF;
    LAS float* wsf = (LAS float*)(lds + L_WS) + wid * 64;
    const int NT = 4 * qb + 4;
    const int qlo = q0 + wid * 32, qpos = qlo + r32;
    const unsigned char* kpes_b = (const unsigned char*)(kpes + rowbase * 64);
    const unsigned char* kvh_b = (const unsigned char*)(kvh + rowbase * 2048 + hl * 256);
    int koff[4]; unsigned kpe_mask = 0u;
#pragma unroll
    for (int i = 0; i < 4; ++i) { const int x = (wid + 8 * i) * 64 + lane; const int row = x / 25; int ch = x - row * 25; if (ch == 24) ch = 23;
        if (ch < 8) { kpe_mask |= 1u << i; koff[i] = row * 128 + ch * 16; } else koff[i] = row * 4096 + (ch - 8) * 16; }
    int voff[2];
#pragma unroll
    for (int i = 0; i < 2; ++i) { const int x = (wid + 8 * i) * 64 + lane; const int sub = x >> 5, within = x & 31; const int kk = (sub >> 2) * 8 + (within >> 2);
        const int k = (kk & ~0xC) | ((kk & 4) << 1) | ((kk & 8) >> 1); voff[i] = k * 4096 + 256 + ((sub & 3) * 32 + (within & 3) * 8) * 2; }
#define GLDS(src, dst) __builtin_amdgcn_global_load_lds((const unsigned*)(src), (LAS unsigned*)(dst), 16, 0, 0)
#define STAGE_DMA(t, buf) do { const size_t ko = (size_t)(t) * 64; \
        _Pragma("unroll") for (int i = 0; i < 4; ++i) if (wid + 8 * i < 25) { \
            const unsigned char* sp_ = ((kpe_mask >> i) & 1u) ? kpes_b + ko * 128 + koff[i] : kvh_b + ko * 4096 + koff[i]; \
            GLDS(sp_, lds + L_K + (buf) * KT + (wid + 8 * i) * 1024); } \
        _Pragma("unroll") for (int i = 0; i < 2; ++i) GLDS(kvh_b + ko * 4096 + voff[i], lds + L_V + (buf) * VT + (wid + 8 * i) * 1024); } while (0)
    bf16x8 qr[12];
    {
        const size_t qrow = rowbase + qpos;
        constexpr int WP = 208, WCH = 192 * WP;
        const unsigned char* wsrc = (const unsigned char*)(mla_w(F.ws, j).wuq + (size_t)h * 192 * 384);
        int wrow[5], wch[5];
#pragma unroll
        for (int i = 0; i < 5; ++i) { const int x = (wid + 8 * i) * 64 + lane; wrow[i] = x / 13; wch[i] = x - wrow[i] * 13; if (wch[i] == 12) wch[i] = 11; }
#define STAGE_W(src, c, bi) do { _Pragma("unroll") for (int i = 0; i < 5; ++i) if (wid + 8 * i < 39) \
            GLDS((src) + (size_t)wrow[i] * 768 + (c) * 192 + wch[i] * 16, lds + (bi) * WCH + (wid + 8 * i) * 1024); } while (0)
        if (!prestaged) { STAGE_W(wsrc, 0, 0); STAGE_W(wsrc, 1, 1); }
        const bf16_t* cqp = pbuf + qrow * M_INP + hi * 8;
        u32x4 cq[24]; float sl[12];
#pragma unroll
        for (int ks = 0; ks < 24; ++ks) cq[ks] = *(const u32x4*)(cqp + ks * 16);
#pragma unroll
        for (int s = 0; s < 12; ++s) sl[s] = ssq1[(size_t)s * T + qrow];
        f32x16 qa[6] = {};
        const LAS unsigned char* wbase = lds + r32 * WP + hi * 16;
#define QMMA(c) do { _Pragma("unroll") for (int i = 0; i < 6; ++i) { _Pragma("unroll") for (int blk = 0; blk < 6; ++blk) { \
            const bf16x8 wa = *(const LAS bf16x8*)(wbase + ((c) & 1) * WCH + blk * 32 * WP + i * 32); \
            qa[blk] = __builtin_amdgcn_mfma_f32_32x32x16_bf16(wa, __builtin_bit_cast(bf16x8, cq[6 * (c) + i]), qa[blk], 0, 0, 0); } } } while (0)
#define BAR_RAW() do { asm volatile("s_waitcnt lgkmcnt(0)" ::: "memory"); __builtin_amdgcn_s_barrier(); asm volatile("" ::: "memory"); } while (0)
        __syncthreads();
        QMMA(0);
        BAR_RAW();
        STAGE_W(wsrc, 2, 0);
        QMMA(1);
        BAR_RAW();
        STAGE_W(wsrc, 3, 1);
        if (wid < 7) asm volatile("s_waitcnt vmcnt(5)" ::: "memory"); else asm volatile("s_waitcnt vmcnt(4)" ::: "memory");
        BAR_RAW();
        QMMA(2);
        asm volatile("s_waitcnt vmcnt(0)" ::: "memory");
        BAR_RAW();
        QMMA(3);
#undef QMMA
        __syncthreads();
        STAGE_DMA(0, 0);
        const LAS float* gql = (const LAS float*)(lds + L_G); const LAS float* gkl = gql + 192;
        float ss = 0.f, sscq = 0.f;
#pragma unroll
        for (int blk = 0; blk < 6; ++blk)
#pragma unroll
            for (int r = 0; r < 16; ++r) ss += qa[blk][r] * qa[blk][r];
        ss = sum_xor32(ss);
#pragma unroll
        for (int s = 0; s < 12; ++s) sscq += sl[s];
        const float a = rsqrtf(sscq * (1.f / 384.f) + EPS);
        const float sc = a * rsqrtf(a * a * ss * (1.f / 192.f) + EPS) * M_SCL2;
        const float* cp = F.cosM() + qrow * 32 + 4 * hi; const float* sp = F.sinM() + qrow * 32 + 4 * hi;
#pragma unroll
        for (int g4 = 0; g4 < 4; ++g4) {
            const f32x4 cs = *(const f32x4*)(cp + 8 * g4), sn = *(const f32x4*)(sp + 8 * g4);
            const f32x4 g1 = *(const LAS f32x4*)(gql + 8 * g4 + 4 * hi), g2 = *(const LAS f32x4*)(gql + 32 + 8 * g4 + 4 * hi);
#pragma unroll
            for (int e = 0; e < 4; ++e) { const int r = 4 * g4 + e; const float u = qa[0][r] * sc * g1[e], v = qa[1][r] * sc * g2[e];
                qa[0][r] = u * cs[e] - v * sn[e]; qa[1][r] = v * cs[e] + u * sn[e]; } }
#pragma unroll
        for (int blk = 2; blk < 6; ++blk)
#pragma unroll
            for (int g4 = 0; g4 < 4; ++g4) { const f32x4 gg = *(const LAS f32x4*)(gkl + 32 * blk + 8 * g4 + 4 * hi);
#pragma unroll
                for (int e = 0; e < 4; ++e) qa[blk][4 * g4 + e] *= sc * gg[e]; }
#pragma unroll
        for (int d0 = 0; d0 < 12; ++d0) { if (d0 & 1) ATT_PK4(qa[d0 >> 1], 8, qr[d0]); else ATT_PK4(qa[d0 >> 1], 0, qr[d0]); }
    }
    __syncthreads();
    float m_reg = -1e30f, l_reg = 0.f; f32x16 o[4] = {};
    const LAS unsigned char* kbase = lds + L_K + r32 * KP + hi * 16;
    const LAS unsigned char* ksb = lds + L_KS + hi * 16;
    const int vb0 = (int)(uintptr_t)(lds + L_V) + v_rd_base(lane);
#define SUBTILE(BUF, t, SUB) do { const int kb0_ = (t) * 64 + 32 * (SUB); \
        if (kb0_ <= qlo + 31 && (MLA_VAR != 8 || wid < 4) && (MLA_VAR != 9 || (wid & 1) == 0)) { f32x16 p = {}; \
            if (MLA_VAR != 4) { bf16x8 kf_[12]; \
                _Pragma("unroll") for (int d0 = 0; d0 < 12; ++d0) kf_[d0] = *(const LAS bf16x8*)(kbase + (BUF) * KT + (SUB) * 32 * KP + d0 * 32); \
                SBAR(); \
                _Pragma("unroll") for (int d0 = 0; d0 < 12; ++d0) p = __builtin_amdgcn_mfma_f32_32x32x16_bf16(kf_[d0], qr[d0], p, 0, 0, 0); } \
            const LAS unsigned char* ksp_ = ksb + kb0_ * 4; const float c0_ = m_reg > -1e29f ? m_reg : 0.f; const f32x2 nc_ = {-c0_, -c0_}; \
            _Pragma("unroll") for (int g = 0; g < 4; ++g) { const f32x4 s0 = *(const LAS f32x4*)(ksp_ + g * 32);            \
                const f32x2 a_ = (f32x2){p[4 * g], p[4 * g + 1]} * (f32x2){s0[0], s0[1]} + nc_, b_ = (f32x2){p[4 * g + 2], p[4 * g + 3]} * (f32x2){s0[2], s0[3]} + nc_; \
                p[4 * g] = a_[0]; p[4 * g + 1] = a_[1]; p[4 * g + 2] = b_[0]; p[4 * g + 3] = b_[1]; } \
            if (kb0_ + 31 > qlo) { const float NEG = -__builtin_inff(); \
                _Pragma("unroll") for (int r = 0; r < 16; ++r) { if (kb0_ + crow(r, hi) > qpos) p[r] = NEG; } } \
            VFrag<4> vf; if (MLA_VAR != 3) v_issue<4, (BUF) * VT + 2 * (SUB) * 4096>(vf, vb0); \
            float alpha = 1.f; bool resc = false; bf16x8 pa0, pa1; \
            softmax_sub_off(p, c0_, m_reg, l_reg, alpha, resc, pa0, pa1); \
            if (resc) { _Pragma("unroll") for (int r = 0; r < 16; ++r) { o[0][r] *= alpha; o[1][r] *= alpha; o[2][r] *= alpha; o[3][r] *= alpha; } }     \
            v_consume<4, true>(o, vf, pa0, pa1); \
        } } while (0)
    for (int t = 0; t < ((MLA_VAR >= 10 && MLA_VAR <= 12) ? 0 : NT); t += 2) {
        if (wid < 4) STAGE_DMA(t + 1, 1);
        SUBTILE(0, t, 0);
        if (wid >= 4) STAGE_DMA(t + 1, 1);
        SUBTILE(0, t, 1);
        __syncthreads();
        if (t + 2 < NT && wid < 4) STAGE_DMA(t + 2, 0);
        SUBTILE(1, t + 1, 0);
        if (t + 2 < NT && wid >= 4) STAGE_DMA(t + 2, 0);
        SUBTILE(1, t + 1, 1);
        __syncthreads();
    }
    if (h_next >= 0) {
        constexpr int WP = 208, WCH = 192 * WP;
        const unsigned char* wsrc = (const unsigned char*)(mla_w(F.ws, j).wuq + (size_t)h_next * 192 * 384);
        int wrow[5], wch[5];
#pragma unroll
        for (int i = 0; i < 5; ++i) { const int x = (wid + 8 * i) * 64 + lane; wrow[i] = x / 13; wch[i] = x - wrow[i] * 13; if (wch[i] == 12) wch[i] = 11; }
        STAGE_W(wsrc, 0, 0); STAGE_W(wsrc, 1, 1);
    }
#undef STAGE_W
#undef BAR_RAW
    {
        const float rl = 1.f / l_reg;
        bf16_t* zrow = pbuf + (rowbase + qpos) * M_INP + M_Z + h * 128 + 8 * hi;
        u32x4 zz[4][2];
#pragma unroll
        for (int d0 = 0; d0 < 4; ++d0)
#pragma unroll
            for (int gp = 0; gp < 2; ++gp) zz[d0][gp] = *(const u32x4*)(zrow + d0 * 32 + gp * 16);
#pragma unroll
        for (int d0 = 0; d0 < 4; ++d0)
#pragma unroll
            for (int gp = 0; gp < 2; ++gp) {
                float ov[8], zf[8];
#pragma unroll
                for (int e = 0; e < 4; ++e) { auto rr = __builtin_amdgcn_permlane32_swap(__float_as_uint(o[d0][8 * gp + e]), __float_as_uint(o[d0][8 * gp + 4 + e]), false, false);
                    ov[e] = __uint_as_float(rr[0]); ov[4 + e] = __uint_as_float(rr[1]); }
                unpack8(zz[d0][gp], zf);
#pragma unroll
                for (int e = 0; e < 8; ++e) ov[e] = ov[e] * rl * zf[e] / (1.f + __expf(-zf[e]));
                if (!dry) *(bf16x8*)(zrow + d0 * 32 + gp * 16) = pack8((f32x4){ov[0], ov[1], ov[2], ov[3]}, (f32x4){ov[4], ov[5], ov[6], ov[7]});
            }
    }
#undef STAGE_DMA
#undef GLDS
#undef SUBTILE
}

__device__ __forceinline__ void phase_attn(Frame& F, int j, int dry) {
    const int bx = blockIdx.x, vcu = (bx & 7) * (GRID / 8) + (bx >> 3);
    { LAS float* gl = (LAS float*)(F.lds + RING_OFF + L_G); const float* gq = F.f(I_MGQ) + j * 192; const float* gk = F.f(I_MGK) + j * 192;
      if (F.tid < 192) { const float g = gq[F.tid]; gl[F.tid] = g; gl[192 + F.tid] = g * gk[F.tid]; } }
    if (F.wave >= 4) __builtin_amdgcn_s_setprio(1);
    for (int it = 0; it < 2; ++it) {
        const int item = it * GRID + vcu, bh = item >> 3, s = item & 7, b = bh >> 4, h = bh & 15;
        {
            const float* ssq1 = F.ssq1(); const float* ssqkn = F.ssqkn() + (size_t)h * 4 * T; LAS float* ksl = (LAS float*)(F.lds + RING_OFF + L_KS);
            const int nk = 256 * (16 - s);
            for (int k0 = 0; k0 < nk; k0 += 4 * NWAVES * 64) { float ssv[4];
#pragma unroll
                for (int u = 0; u < 4; ++u) { const int k = k0 + u * NWAVES * 64 + F.tid; const size_t kr = (size_t)b * SEQ + (k < nk ? k : 0);
                    ssv[u] = (ssq1[(size_t)20 * T + kr] + ssq1[(size_t)21 * T + kr]) + (ssqkn[kr] + ssqkn[T + kr]) + (ssqkn[2 * (size_t)T + kr] + ssqkn[3 * (size_t)T + kr]); }
#pragma unroll
                for (int u = 0; u < 4; ++u) { const int k = k0 + u * NWAVES * 64 + F.tid; if (k < nk) ksl[k] = rsqrtf(ssv[u] * (1.f / 192.f) + EPS); } }
            __syncthreads();
        }
        const int h2 = (((it + 1) * GRID + vcu) >> 3) & 15;
        attn_unit(F, j, b, h, 15 - s, dry, it == 1, h);
        attn_unit(F, j, b, h, s, dry, true, it == 0 ? h2 : -1);
    }
    __builtin_amdgcn_s_setprio(0);
}
}
namespace nsap {
using namespace att;
__device__ __forceinline__ void post_rows(Frame& F, int j, int dry) {
    int tid_ = F.tid; asm volatile("" : "+v"(tid_));
    const int tid = tid_, lane = tid & 63, wid = __builtin_amdgcn_readfirstlane(tid >> 6);
    bf16_t* pbuf = F.p1(); const float* gq = F.f(I_NGQ) + j * 96; const float* gk = F.f(I_NGK) + j * 288;
    const float* cosN = F.cosN(); const float* sinN = F.sinN();
    const int part = lane & 3;
    constexpr int NU = T * 8;
    for (int u0 = (blockIdx.x * NWAVES + wid) * 32 + (lane >> 2); u0 < NU; u0 += GRID * NWAVES * 32) {
        bf16_t* p[2]; const float* g[2]; float post[2]; int row[2]; float x[2][24];
#pragma unroll
        for (int k = 0; k < 2; ++k) { const int u = u0 + 16 * k; row[k] = u >> 3; const int un = u & 7;
            if (un < 4) { p[k] = pbuf + (size_t)row[k] * N_INP + N_KS + un * 96 + part * 24; g[k] = gk + 96 + part * 24; post[k] = 1.f; }
            else { p[k] = pbuf + (size_t)row[k] * N_INP + N_KW + (un - 4) * 96 + part * 24; g[k] = gk + 192 + part * 24; post[k] = 1.f; }
#pragma unroll
            for (int i = 0; i < 3; ++i) unpack8(*(const u32x4*)(p[k] + 8 * i), x[k] + 8 * i); }
#pragma unroll
        for (int k = 0; k < 2; ++k) { float ss = 0.f;
#pragma unroll
            for (int i = 0; i < 24; ++i) ss += x[k][i] * x[k][i];
            ss += get_xor1(ss); ss += get_xor2(ss);
            const float r = rsqrtf(ss * (1.f / 96.f) + EPS) * post[k];
#pragma unroll
            for (int i = 0; i < 24; ++i) x[k][i] *= r * g[k][i];
            if (part == 0) {
#pragma unroll
                for (int f = 0; f < 12; ++f) { const float c = cosN[row[k] * 12 + f], s = sinN[row[k] * 12 + f]; const float a = x[k][f], b2 = x[k][12 + f]; x[k][f] = a * c - b2 * s; x[k][12 + f] = b2 * c + a * s; } }
#pragma unroll
            for (int i = 0; i < 3; ++i) if (!dry) *(bf16x8*)(p[k] + 8 * i) = pack8((f32x4){x[k][8 * i], x[k][8 * i + 1], x[k][8 * i + 2], x[k][8 * i + 3]}, (f32x4){x[k][8 * i + 4], x[k][8 * i + 5], x[k][8 * i + 6], x[k][8 * i + 7]}); }
    }
}

constexpr int L_PART = 0, L_HID = 8 * 32 * 96 * 4, L_OUT = L_HID + 32 * 96 * 2, L_CEND = L_OUT + 32 * 96 * 4;
static_assert(L_CEND <= RING_BYTES, "compress LDS");
template <int DD>
__device__ __forceinline__ void compress_unit(Frame& F, int j, int b, int g, int nb) {
    int tid_ = F.tid; asm volatile("" : "+v"(tid_));
    const int tid = tid_, lane = tid & 63, wid = __builtin_amdgcn_readfirstlane(tid >> 6), r32 = lane & 31, hi = lane >> 5;
    constexpr int NC = DD / 32, KPT = DD / 16, KTOT = 32 * DD, COFF = DD == 96 ? N_KC : N_VC;
    const NsaW W = nsa_w(F.ws, j);
    const bf16_t* w1t = DD == 96 ? W.w1k : W.w1v; const bf16_t* w2t = DD == 96 ? W.w2k : W.w2v;
    const float* pe = (DD == 96 ? F.f(I_NPEK) + j * 32 * 96 : F.f(I_NPEV) + j * 32 * 64) + hi * 8;
    const bf16_t* pbuf = F.p1(); LAS unsigned char* lds = F.lds + RING_OFF;
    const size_t rowbase = (size_t)b * SEQ;
    int n = 32 * nb + r32; if (n > NCMP - 1) n = NCMP - 1;
    f32x16 acc[NC] = {};
#pragma unroll 2
    for (int li = 0; li < 4; ++li) {
        const int l = 4 * wid + li;
        const bf16_t* ap = pbuf + (rowbase + 16 * n + l) * N_INP + COFF + g * DD + hi * 8;
        const bf16_t* bp = w1t + (size_t)r32 * KTOT + l * DD + hi * 8;
#pragma unroll
        for (int kk = 0; kk < KPT; ++kk) {
            float af[8]; unpack8(*(const u32x4*)(ap + kk * 16), af);
            const f32x4 pe0 = *(const f32x4*)(pe + l * DD + kk * 16), pe1 = *(const f32x4*)(pe + l * DD + kk * 16 + 4);
            const bf16x8 a = pack8((f32x4){af[0] + pe0[0], af[1] + pe0[1], af[2] + pe0[2], af[3] + pe0[3]}, (f32x4){af[4] + pe1[0], af[5] + pe1[1], af[6] + pe1[2], af[7] + pe1[3]});
#pragma unroll
            for (int cb = 0; cb < NC; ++cb) { const bf16x8 bb = *(const bf16x8*)(bp + (size_t)cb * 32 * KTOT + kk * 16);
                acc[cb] = __builtin_amdgcn_mfma_f32_32x32x16_bf16(a, bb, acc[cb], 0, 0, 0); }
        }
    }
    LAS float* part = (LAS float*)(lds + L_PART) + wid * 32 * DD;
#pragma unroll
    for (int cb = 0; cb < NC; ++cb)
#pragma unroll
        for (int r = 0; r < 16; ++r) part[crow(r, hi) * DD + cb * 32 + r32] = acc[cb][r];
    __syncthreads();
    LAS bf16_t* hid = (LAS bf16_t*)(lds + L_HID);
    for (int e = tid; e < 32 * DD; e += NWAVES * 64) { float s = 0.f;
#pragma unroll
        for (int w = 0; w < 8; ++w) s += ((LAS float*)(lds + L_PART))[w * 32 * DD + e];
        hid[e] = f2bf(s / (1.f + __expf(-s))); }
    __syncthreads();
    LAS float* outl = (LAS float*)(lds + L_OUT);
    if (wid < NC) {
        f32x16 a2 = {};
#pragma unroll
        for (int kk = 0; kk < KPT; ++kk) {
            const bf16x8 a = *(const LAS bf16x8*)(hid + r32 * DD + kk * 16 + hi * 8);
            const bf16x8 bb = *(const bf16x8*)(w2t + (size_t)(wid * 32 + r32) * DD + kk * 16 + hi * 8);
            a2 = __builtin_amdgcn_mfma_f32_32x32x16_bf16(a, bb, a2, 0, 0, 0);
        }
#pragma unroll
        for (int r = 0; r < 16; ++r) outl[crow(r, hi) * DD + wid * 32 + r32] = a2[r];
    }
    __syncthreads();
    if constexpr (DD == 96) {
        if (tid < 128) {
            const int row = tid >> 2, prt = tid & 3, nn = 32 * nb + row;
            const float* g0 = F.f(I_NGK) + j * 288 + prt * 24;
            float x[24]; float ss = 0.f;
#pragma unroll
            for (int i = 0; i < 24; ++i) { x[i] = outl[row * 96 + prt * 24 + i]; ss += x[i] * x[i]; }
            ss += get_xor1(ss); ss += get_xor2(ss);
            const float r = rsqrtf(ss * (1.f / 96.f) + EPS);
#pragma unroll
            for (int i = 0; i < 24; ++i) x[i] *= r * g0[i];
            if (prt == 0) { const size_t tp = rowbase + 16 * nn + 31; const float* cp = F.cosN() + tp * 12; const float* sp = F.sinN() + tp * 12;
                if (nn < NCMP) {
#pragma unroll
                    for (int f = 0; f < 12; ++f) { const float c = cp[f], s = sp[f]; const float a = x[f], b2 = x[12 + f]; x[f] = a * c - b2 * s; x[12 + f] = b2 * c + a * s; } } }
            if (nn >= NCMP) {
#pragma unroll
                for (int i = 0; i < 24; ++i) x[i] = 0.f; }
            bf16_t* dst = F.kcmp() + (((size_t)b * 4 + g) * 256 + nn) * 96 + prt * 24;
#pragma unroll
            for (int i = 0; i < 3; ++i) *(bf16x8*)(dst + 8 * i) = pack8((f32x4){x[8 * i], x[8 * i + 1], x[8 * i + 2], x[8 * i + 3]}, (f32x4){x[8 * i + 4], x[8 * i + 5], x[8 * i + 6], x[8 * i + 7]});
        }
    } else {
        if (tid < 256) {
            const int row = tid >> 3, ch = tid & 7, nn = 32 * nb + row; float x[8];
#pragma unroll
            for (int i = 0; i < 8; ++i) x[i] = nn < NCMP ? outl[row * 64 + ch * 8 + i] : 0.f;
            *(bf16x8*)(F.vcmp() + (((size_t)b * 4 + g) * 256 + nn) * 64 + ch * 8) = pack8((f32x4){x[0], x[1], x[2], x[3]}, (f32x4){x[4], x[5], x[6], x[7]});
        }
    }
    __syncthreads();
}

__device__ __forceinline__ void phase_post(Frame& F, int j, int dry) {
    const int u = blockIdx.x;
    const int kind = u >> 7, r = u & 127, b = r >> 5, g = (r >> 3) & 3, nb = r & 7;
    if (kind == 0) compress_unit<96>(F, j, b, g, nb); else compress_unit<64>(F, j, b, g, nb);
    post_rows(F, j, dry);
}
}
namespace nsa {
using namespace att;
constexpr int KP = 208, KT = 64 * KP, VT = 16384;
constexpr int L_K = 0, L_V = 2 * KT, L_IMP = L_V + 2 * VT, L_SELM = L_IMP + 64 * 64 * 4, L_SCJ = L_SELM + 512, L_WS = L_SCJ + NWAVES * 256, L_GATE = L_WS + NWAVES * 256,
              L_UNI = L_GATE + NWAVES * 512, L_END = L_UNI + 16;
static_assert(L_END <= RING_BYTES, "NSA attention LDS");

__device__ __forceinline__ void attn_unit(Frame& F, int jl, int b, int g, int c, int dry) {
    int tid_ = F.tid; asm volatile("" : "+v"(tid_));
    const int tid = tid_, lane = tid & 63, wid = __builtin_amdgcn_readfirstlane(tid >> 6), r32 = lane & 31, hi = lane >> 5;
    LAS unsigned char* lds = F.lds + RING_OFF;
    bf16_t* pbuf = F.p1();
    const size_t rowbase = (size_t)b * SEQ;
    const int tpos = 64 * c + 8 * wid + (r32 >> 2);
    int krow[2], kch[2];
#pragma unroll
    for (int i = 0; i < 2; ++i) { const int x = (wid + 8 * i) * 64 + lane; krow[i] = x / 13; kch[i] = x - krow[i] * 13; if (kch[i] == 12) kch[i] = 11; }
    int vk2, vc2, vk4, vc4;
    { const int sub = wid * 2 + (lane >> 5), within = lane & 31; const int kk = (sub >> 1) * 8 + (within >> 2); vk2 = (kk & ~0xC) | ((kk & 4) << 1) | ((kk & 8) >> 1); vc2 = (sub & 1) * 32 + (within & 3) * 8; }
    { const int within = lane & 31; const int kk = wid * 8 + (within >> 2); vk4 = (kk & ~0xC) | ((kk & 4) << 1) | ((kk & 8) >> 1); vc4 = (lane >> 5) * 32 + (within & 3) * 8; }
#define GLDS(src, dst) __builtin_amdgcn_global_load_lds((const unsigned*)(src), (LAS unsigned*)(dst), 16, 0, 0)
#define STAGE_K(buf, kptr, kstride, row0) do { _Pragma("unroll") for (int i = 0; i < 2; ++i) if (wid + 8 * i < 13) \
        GLDS((const unsigned char*)(kptr) + (size_t)((row0) + krow[i]) * (kstride) + kch[i] * 16, lds + L_K + (buf) * KT + (wid + 8 * i) * 1024); } while (0)
    bf16x8 qr[6]; float gate[3];
#define Q_AND_GATES() do { \
    { const size_t qrow_ = rowbase + tpos; const bf16_t* qp = pbuf + qrow_ * N_INP + N_Q + (4 * g + (r32 & 3)) * 96 + hi * 8; \
      const float* gq_ = F.f(I_NGQ) + jl * 96 + hi * 8; const float* cp_ = F.cosN() + qrow_ * 12; const float* sp_ = F.sinN() + qrow_ * 12; \
      u32x4 raw_[6]; f32x4 gg_[6][2]; f32x4 cs_[3], sn_[3]; \
      for (int d0 = 0; d0 < 6; ++d0) { raw_[d0] = *(const u32x4*)(qp + d0 * 16); gg_[d0][0] = *(const f32x4*)(gq_ + d0 * 16); gg_[d0][1] = *(const f32x4*)(gq_ + d0 * 16 + 4); } \
      for (int i = 0; i < 3; ++i) { cs_[i] = *(const f32x4*)(cp_ + 4 * i); sn_[i] = *(const f32x4*)(sp_ + 4 * i); } \
      float x_[6][8]; float ss_ = 0.f; \
      for (int d0 = 0; d0 < 6; ++d0) { unpack8(raw_[d0], x_[d0]); for (int e = 0; e < 8; ++e) ss_ += x_[d0][e] * x_[d0][e]; } \
      ss_ = sum_xor32(ss_); \
      const float rn_ = rsqrtf(ss_ * (1.f / 96.f) + EPS) * N_SCL2; \
      for (int d0 = 0; d0 < 6; ++d0) for (int e = 0; e < 8; ++e) x_[d0][e] *= rn_ * gg_[d0][e >> 2][e & 3]; \
      float y0_[8], y1_[4]; \
      for (int e = 0; e < 8; ++e) y0_[e] = get_xor32(x_[0][e], hi);            \
      for (int e = 0; e < 4; ++e) y1_[e] = get_xor32(x_[1][4 + e], hi);        \
      if (hi == 0) { \
          for (int e = 0; e < 4; ++e) { const float a_ = x_[0][e], b_ = y0_[4 + e]; x_[0][e] = a_ * cs_[0][e] - b_ * sn_[0][e]; }                           \
          for (int e = 0; e < 4; ++e) { const float a_ = x_[0][4 + e], b_ = x_[1][e]; x_[0][4 + e] = a_ * cs_[1][e] - b_ * sn_[1][e]; x_[1][e] = b_ * cs_[1][e] + a_ * sn_[1][e]; }     \
          for (int e = 0; e < 4; ++e) { const float a_ = y0_[e], b_ = x_[1][4 + e]; x_[1][4 + e] = b_ * cs_[2][e] + a_ * sn_[2][e]; }                       \
      } else { \
          for (int e = 0; e < 4; ++e) { const float a_ = x_[0][e], b_ = y1_[e]; x_[0][e] = a_ * cs_[2][e] - b_ * sn_[2][e]; }                               \
          for (int e = 0; e < 4; ++e) { const float a_ = y0_[e], b_ = x_[0][4 + e]; x_[0][4 + e] = b_ * cs_[0][e] + a_ * sn_[0][e]; }                       \
      } \
      for (int d0 = 0; d0 < 6; ++d0) qr[d0] = pack8((f32x4){x_[d0][0], x_[d0][1], x_[d0][2], x_[d0][3]}, (f32x4){x_[d0][4], x_[d0][5], x_[d0][6], x_[d0][7]}); } \
    { const bf16_t* gp = pbuf + (rowbase + tpos) * N_INP + N_GL + (4 * g + (r32 & 3)) * 3; \
        for (int i = 0; i < 3; ++i) gate[i] = 1.f / (1.f + __expf(-bf2f(gp[i]))); } \
    } while (0)
    const LAS unsigned char* kbase = lds + L_K + r32 * KP + hi * 16;
    const int vb0 = (int)(uintptr_t)(lds + L_V) + v_rd_base(lane);
    float m_reg, l_reg; int lo_lim, hi_lim;
    f32x16 acc[2] = {};
#define TILE64(NB, BUF, kb0, O, WACT, SELOK) do { const int kb0_ = (kb0); \
        if ((WACT) && __any(hi_lim >= kb0_ && lo_lim <= kb0_ + 63)) { \
            const float c0_ = m_reg > -1e29f ? m_reg : 0.f; const float pi_ = (SELOK) ? -c0_ : -__builtin_inff(); f32x16 p0, p1; \
            _Pragma("unroll") for (int r = 0; r < 16; ++r) { p0[r] = pi_; p1[r] = pi_; } \
            { bf16x8 kf_[12]; \
              _Pragma("unroll") for (int d0 = 0; d0 < 6; ++d0) { kf_[2 * d0] = *(const LAS bf16x8*)(kbase + (BUF) * KT + d0 * 32); kf_[2 * d0 + 1] = *(const LAS bf16x8*)(kbase + (BUF) * KT + 32 * KP + d0 * 32); } \
              SBAR(); \
              _Pragma("unroll") for (int d0 = 0; d0 < 6; ++d0) { p0 = __builtin_amdgcn_mfma_f32_32x32x16_bf16(kf_[2 * d0], qr[d0], p0, 0, 0, 0); p1 = __builtin_amdgcn_mfma_f32_32x32x16_bf16(kf_[2 * d0 + 1], qr[d0], p1, 0, 0, 0); } } \
            if (__any(kb0_ + 63 > hi_lim || kb0_ < lo_lim)) { const float NEG = -__builtin_inff(); \
                _Pragma("unroll") for (int r = 0; r < 16; ++r) { const int kk_ = kb0_ + crow(r, hi); if (kk_ > hi_lim || kk_ < lo_lim) p0[r] = NEG; if (kk_ + 32 > hi_lim || kk_ + 32 < lo_lim) p1[r] = NEG; } } \
            VFrag<NB> va, vb; v_issue<NB, (BUF) * VT>(va, vb0); if (NB == 2) v_issue<NB, (BUF) * VT + 2 * NB * 1024>(vb, vb0); \
            float alpha; bool resc; bf16x8 pa0, pa1, pa2, pa3; \
            softmax64_off(p0, p1, c0_, m_reg, l_reg, alpha, resc, pa0, pa1, pa2, pa3); \
            if (resc) { _Pragma("unroll") for (int r = 0; r < 16; ++r) { _Pragma("unroll") for (int d_ = 0; d_ < NB; ++d_) O[d_][r] *= alpha; } }     \
            v_consume<NB, true>(O, va, pa0, pa1); \
            if (NB != 2) v_issue<NB, (BUF) * VT + 2 * NB * 1024>(vb, vb0); \
            v_consume<NB, true>(O, vb, pa2, pa3); \
        } } while (0)
    {
        const bf16_t* kc = F.kcmp() + ((size_t)b * 4 + g) * 256 * 96; const bf16_t* vc = F.vcmp() + ((size_t)b * 4 + g) * 256 * 64;
        f32x16 o[4] = {}; m_reg = -1e30f; l_reg = 0.f;
        hi_lim = (tpos - 31) >> 4; lo_lim = -(1 << 30);
        const int ntc = (NSA_VAR == 10 || NSA_VAR == 13) ? 0 : (4 * c + 3) / 64 + 1;
#define STAGE_C(t, buf) do { STAGE_K(buf, kc, 192, (t) * 64); \
        GLDS((const unsigned char*)vc + (size_t)((t) * 64 + vk4) * 128 + vc4 * 2, lds + L_V + (buf) * VT + (2 * wid) * 1024); \
        { const int n_ = (t) * 64 + vk4; const int j0_ = vc4; unsigned w_[4]; \
          _Pragma("unroll") for (int e = 0; e < 4; ++e) { const int ja = j0_ + 2 * e, jb = ja + 1; \
              w_[e] = ((n_ >= 4 * ja - 1 && n_ <= 4 * ja + 3) ? 0x3f80u : 0u) | ((n_ >= 4 * jb - 1 && n_ <= 4 * jb + 3) ? 0x3f800000u : 0u); } \
          *(LAS u32x4*)(lds + L_V + (buf) * VT + (2 * wid + 1) * 1024 + lane * 16) = (u32x4){w_[0], w_[1], w_[2], w_[3]}; } } while (0)
        if (ntc) STAGE_C(0, 0);
        Q_AND_GATES();
        __syncthreads();
        for (int t = 0; t < ntc; t += 2) {
            if (t + 1 < ntc) STAGE_C(t + 1, 1);
            TILE64(4, 0, t * 64, o, true, true);
            __syncthreads();
            if (t + 1 < ntc) {
                if (t + 2 < ntc) STAGE_C(t + 2, 0);
                TILE64(4, 1, (t + 1) * 64, o, true, true);
                __syncthreads();
            }
        }
#undef STAGE_C
        {
            const float rl = l_reg > 0.f ? 1.f / l_reg : 0.f, gr = gate[0] * rl;
            LAS float* imp = (LAS float*)(lds + L_IMP) + (8 * wid + (r32 >> 2)) * 64 + 4 * hi;
#pragma unroll
            for (int r = 0; r < 16; ++r) { acc[0][r] = o[0][r] * gr; acc[1][r] = o[1][r] * gr; }
#pragma unroll
            for (int d = 0; d < 2; ++d)
#pragma unroll
                for (int q4 = 0; q4 < 4; ++q4) { f32x4 iv;
#pragma unroll
                    for (int e = 0; e < 4; ++e) { float v = o[2 + d][4 * q4 + e] * rl; v += get_xor1(v); v += get_xor2(v); iv[e] = v; }
                    if ((r32 & 3) == 0) *(LAS f32x4*)(imp + d * 32 + 8 * q4) = iv; }
        }
    }
#define STAGE_SW(j, buf, koffc, voffc) do { STAGE_K(buf, pbuf + rowbase * N_INP + (koffc) + g * 96, N_INP * 2, (j) * 64); \
    GLDS((const unsigned char*)(pbuf + rowbase * N_INP + (voffc) + g * 64) + (size_t)((j) * 64 + vk2) * (N_INP * 2) + vc2 * 2, lds + L_V + (buf) * VT + wid * 1024); } while (0)
    STAGE_SW(0, 0, N_KS, N_VS);
    unsigned long long mysel = 0ull, wsel = 0ull;
    {
        LAS float* imp = (LAS float*)(lds + L_IMP); LAS float* scj = (LAS float*)(lds + L_SCJ) + wid * 64;
        LAS unsigned long long* selm = (LAS unsigned long long*)(lds + L_SELM);
        asm volatile("s_waitcnt lgkmcnt(0)" ::: "memory");
        if (!(NSA_VAR == 7 || NSA_VAR == 12 || NSA_VAR == 13)) {
            const int j = lane; const bool forced = (j == 0) || (j == c) || (j == c - 1);
            unsigned key[8], prefix[8];
#pragma unroll
            for (int tl = 0; tl < 8; ++tl) { const float v = imp[(8 * wid + tl) * 64 + j]; const float me = forced ? 1e4f : ((j <= c) ? v : -1.f);
                const unsigned ub = __float_as_uint(me); key[tl] = (ub & 0x80000000u) ? ~ub : (ub | 0x80000000u); prefix[tl] = 0u; }
            for (int bit = 31; bit >= 0; --bit) {
#pragma unroll
                for (int tl = 0; tl < 8; ++tl) { const unsigned cand = prefix[tl] | (1u << bit); const int cnt = __builtin_popcountll(__ballot(key[tl] >= cand)); if (cnt >= 16) prefix[tl] = cand; }
            }
#pragma unroll
            for (int tl = 0; tl < 8; ++tl) {
                const unsigned long long gt = __ballot(key[tl] > prefix[tl]), eq = __ballot(key[tl] == prefix[tl]);
                const int need = 16 - __builtin_popcountll(gt);
                const int below = __builtin_popcountll(eq & ((1ull << j) - 1ull));
                const unsigned long long mk = gt | __ballot(key[tl] == prefix[tl] && below < need);
                wsel |= mk; if (tl == (r32 >> 2)) mysel = mk;
            }
        }
        LAS unsigned* uni = (LAS unsigned*)(lds + L_UNI);
        if (tid < 2) uni[tid] = 0u;
        __syncthreads();
        if (lane == 0) { __hip_atomic_fetch_or(uni, (unsigned)wsel, __ATOMIC_RELAXED, __HIP_MEMORY_SCOPE_WORKGROUP); __hip_atomic_fetch_or(uni + 1, (unsigned)(wsel >> 32), __ATOMIC_RELAXED, __HIP_MEMORY_SCOPE_WORKGROUP); }
        __syncthreads();
    }
    bf16_t* zrow = pbuf + (rowbase + tpos) * N_INP + N_Z + (4 * g + (r32 & 3)) * 64 + 8 * hi;
    u32x4 zz[2][2];
    {
        const LAS unsigned* uni = (const LAS unsigned*)(lds + L_UNI);
        const unsigned long long usel = ((unsigned long long)uni[1] << 32) | uni[0];
        const unsigned long long call = (c == 63) ? ~0ull : ((1ull << (c + 1)) - 1ull);
        for (int br = 0; br < 2; ++br) {
            if (br == 1) {
#pragma unroll
                for (int d0 = 0; d0 < 2; ++d0)
#pragma unroll
                    for (int gp = 0; gp < 2; ++gp) zz[d0][gp] = *(const u32x4*)(zrow + d0 * 32 + gp * 16); }
            unsigned long long tm = br == 0 ? (usel & call) : (call & ~((c >= 9) ? ((1ull << (c - 8)) - 1ull) : 0ull));
            const int koffc = br == 0 ? N_KS : N_KW, voffc = br == 0 ? N_VS : N_VW;
            f32x16 o[2] = {}; m_reg = -1e30f; l_reg = 0.f;
            bool wact, selok; hi_lim = tpos; lo_lim = br == 0 ? -(1 << 30) : tpos - 511;
#define SETLIM() do { selok = br != 0 || ((mysel >> cur) & 1ull); wact = br != 0 || ((wsel >> cur) & 1ull); } while (0)
            int cur = __builtin_ctzll(tm); tm &= tm - 1;
            if (br != 0) STAGE_SW(cur, 0, koffc, voffc);
            __syncthreads();
            for (;;) {
                int nxt = tm ? __builtin_ctzll(tm) : -1; tm &= tm - 1;
                if (nxt >= 0) STAGE_SW(nxt, 1, koffc, voffc);
                SETLIM();
                TILE64(2, 0, cur * 64, o, wact, selok);
                __syncthreads();
                cur = nxt; if (cur < 0) break;
                nxt = tm ? __builtin_ctzll(tm) : -1; tm &= tm - 1;
                if (nxt >= 0) STAGE_SW(nxt, 0, koffc, voffc);
                SETLIM();
                TILE64(2, 1, cur * 64, o, wact, selok);
                __syncthreads();
                cur = nxt; if (cur < 0) break;
            }
            { const float gr = (br == 0 ? gate[1] : gate[2]) * (l_reg > 0.f ? 1.f / l_reg : 0.f);
#pragma unroll
              for (int r = 0; r < 16; ++r) { acc[0][r] += o[0][r] * gr; acc[1][r] += o[1][r] * gr; } }
        }
#undef STAGE_SW
    }
    {
#pragma unroll
        for (int d0 = 0; d0 < 2; ++d0)
#pragma unroll
            for (int gp = 0; gp < 2; ++gp) {
                float ov[8], zf[8];
#pragma unroll
                for (int e = 0; e < 4; ++e) { auto rr = __builtin_amdgcn_permlane32_swap(__float_as_uint(acc[d0][8 * gp + e]), __float_as_uint(acc[d0][8 * gp + 4 + e]), false, false);
                    ov[e] = __uint_as_float(rr[0]); ov[4 + e] = __uint_as_float(rr[1]); }
                unpack8(zz[d0][gp], zf);
#pragma unroll
                for (int e = 0; e < 8; ++e) ov[e] = ov[e] * zf[e] / (1.f + __expf(-zf[e]));
                if (!dry) *(bf16x8*)(zrow + d0 * 32 + gp * 16) = pack8((f32x4){ov[0], ov[1], ov[2], ov[3]}, (f32x4){ov[4], ov[5], ov[6], ov[7]});
            }
    }
    __syncthreads();
#undef TILE64
#undef SETLIM
#undef Q_AND_GATES
#undef STAGE_K
#undef GLDS
}

__device__ __forceinline__ void phase_attn(Frame& F, int jl, int dry) {
    const int bx = blockIdx.x, vcu = (bx & 7) * (GRID / 8) + (bx >> 3);
    if (F.wave >= 4) __builtin_amdgcn_s_setprio(1);
    for (int it = 0; it < 2; ++it) {
        const int item = vcu * 2 + it, bg = item >> 5, s = item & 31;
        for (int pass = 0; pass < 2; ++pass) attn_unit(F, jl, bg >> 2, bg & 3, pass ? s : 63 - s, dry);
    }
    __builtin_amdgcn_s_setprio(0);
}
}

__global__ void __launch_bounds__(NWAVES * 64, 2) mk_fwd(Args args) {
    extern __shared__ __attribute__((aligned(16))) unsigned char lds_raw[];
    Frame F;
    F.lds = (LAS unsigned char*)lds_raw;
    F.tid = threadIdx.x; F.lane = F.tid & 63; F.wave = __builtin_amdgcn_readfirstlane(F.tid >> 6); F.G = gridDim.x;
    F.in = args.in; F.out = args.out; F.ws = args.ws;
    volatile LAS unsigned* MISC = (volatile LAS unsigned*)(F.lds + MISC_OFF);
    if (F.tid < 128) ((LAS unsigned*)(F.lds + LDSCTL_OFF))[F.tid] = 0u;
    __syncthreads();
    const int lo = args.ph_lo, hi = args.ph_hi;
    XcdBarrier bar; bar.bar = (unsigned*)(F.ws + WS_CTL) + CW_BAR; bar.x = 0; bar.st = nullptr;
    if (hi - lo > 1) bar = xcd_barrier_post((unsigned*)(F.ws + WS_CTL) + CW_BAR, MISC + 8);
    for (int ph = lo; ph < hi; ++ph) {
        const PhaseDesc pd = decode_phase(ph);
        { int t_ = threadIdx.x; asm volatile("" : "+v"(t_)); F.tid = t_; F.lane = t_ & 63; }
        { unsigned char* w_ = args.ws; float* o_ = args.out; asm volatile("" : "+s"(w_), "+s"(o_)); F.ws = w_; F.out = o_; }
        const int dry = args.dry;
        switch (pd.kind) {
        case K_PROLOGUE: pro::phase_prologue(F); break;
        case K_MLA_G1: case K_MLA_G2: case K_NSA_G1: {
            if (pd.kind == K_MLA_G2) phase_kpes(F, pd.j);
            pg8::Gemm g; pg8::EpiBf16RS E;
            if (pd.kind == K_MLA_G1) { const MlaW w = mla_w(F.ws, pd.j); g = pg8::Gemm{F.xb(), w.win, T, M_INP, 1024, DM}; E = pg8::EpiBf16RS{F.p1(), M_INP, F.ssqx(), 4, 1.f / 1024.f, dry >= 2 ? dry - 1 : 0, F.ssq1(), 1, F.lds + RING_OFF, nullptr, 0}; }
            else if (pd.kind == K_NSA_G1) { const NsaW w = nsa_w(F.ws, pd.j); g = pg8::Gemm{F.xb(), w.win, T, N_INP, 1024, DM}; E = pg8::EpiBf16RS{F.p1(), N_INP, F.ssqx(), 4, 1.f / 1024.f, dry >= 2 ? dry - 1 : 0, nullptr, 0, F.lds + RING_OFF, nullptr, 0}; }
            else { const MlaW w = mla_w(F.ws, pd.j); g = pg8::Gemm{F.p1() + M_CKV, w.wukv, T, 4096, 256, M_INP};
                   E = pg8::EpiBf16RS{F.kvh(), 2048, F.ssq1() + (size_t)12 * T, 8, 1.f / 256.f, dry >= 2 ? dry - 1 : 0, F.ssqkn(), 2, F.lds + RING_OFF, F.kvh2(), 8}; }
            pg8::OrderRS S; S.init(g.M, g.N, F.G, (int)blockIdx.x); S.rs_ssq = E.rs_ssq; S.rs_nslot = E.rs_nslot; S.lds = F.lds + RING_OFF;
            pg8::gemm_phase<pg8::EpiBf16RS, pg8::OrderRS, true, true>(F.lds + RING_OFF, g, S, E);
        } break;
        case K_OUT: {
            pg8::Gemm g;
            if ((pd.L & 1) == 0) { const MlaW w = mla_w(F.ws, pd.j); g = pg8::Gemm{F.p1() + M_Z, w.wout, T, DM, 2048, M_INP}; }
            else { const NsaW w = nsa_w(F.ws, pd.j); g = pg8::Gemm{F.p1() + N_Z, w.wout, T, DM, 1024, N_INP}; }
            pg8::EpiResid E{pd.L == 0 ? F.f(I_X) : nullptr, F.xb(), pd.L == 3 ? F.out : nullptr, F.ssqx(), dry};
            pg8::StaticOrder S; S.init(T, DM, F.G, (int)blockIdx.x);
            pg8::gemm_phase<pg8::EpiResid, pg8::StaticOrder, false, true>(F.lds + RING_OFF, g, S, E);
        } break;
        case K_MLA_ATT: mla::phase_attn(F, pd.j, dry); break;
        case K_NSA_POST: nsap::phase_post(F, pd.j, dry); break;
        case K_NSA_ATT: nsa::phase_attn(F, pd.j, dry); break;
        default: break;
        }
        if (ph + 1 < hi) xcd_barrier(bar);
    }
}
extern "C" void kernel_launch(void* const* d_in, const int* in_sizes, int n_in, void* d_out, int out_size, void* d_ws, size_t ws_size, hipStream_t stream) {
    if (n_in != N_INPUTS || in_sizes[I_X] != T * DM || out_size != T * DM || ws_size < 256 * MiB) { fprintf(stderr, "kernel_launch: unexpected shapes (n_in %d, out %d, ws %zu); nothing launched\n", n_in, out_size, ws_size); return; }
    static bool attr_done = false;
    if (!attr_done) { attr_done = true;
        if (hipFuncSetAttribute((const void*)mk_fwd, hipFuncAttributeMaxDynamicSharedMemorySize, LDS_BYTES) != hipSuccess) fprintf(stderr, "kernel_launch: hipFuncSetAttribute(%d B LDS) failed\n", LDS_BYTES); }
    (void)hipMemsetAsync((char*)d_ws + WS_CTL, 0, 1 * MiB, stream);
    Args a{};
    for (int i = 0; i < N_INPUTS; ++i) a.in[i] = d_in[i];
    a.out = (float*)d_out; a.ws = (unsigned char*)d_ws; a.ph_lo = 0; a.ph_hi = N_PHASES; a.dry = 0; a.pad = 0;
    hipLaunchKernelGGL(mk_fwd, dim3(GRID), dim3(NWAVES * 64), LDS_BYTES, stream, a);
    const hipError_t le = hipPeekAtLastError();
    if (le != hipSuccess) fprintf(stderr, "kernel_launch: launch failed: %s\n", hipGetErrorName(le));
}
```

```cpp
#include <hip/hip_runtime.h>
#include <stdint.h>
#include <stdio.h>

typedef unsigned short bf16_t;

constexpr int T = 16384, DM = 1024, NB = 4, SEQ = 4096;
constexpr float EPS = 1e-6f;
constexpr int M_INP = 2816, M_IN = 2752, M_CKV = 384, M_KPE = 640, M_Z = 704;
constexpr int N_INP = 4608, N_IN = 4528;
constexpr int N_Q = 0, N_KC = 1536, N_VC = 1920, N_KS = 2176, N_VS = 2560, N_KW = 2816, N_VW = 3200, N_GL = 3456, N_Z = 3504;
constexpr int NCMP = 255;
constexpr float LOG2E = 1.4426950408889634f;
constexpr float M_SCL2 = 0.07216878364870322f * LOG2E;
constexpr float N_SCL2 = 0.10206207261596575f * LOG2E;

constexpr size_t MiB = 1u << 20;
constexpr size_t WS_CTL = 0;
constexpr size_t WS_COSM = 1 * MiB, WS_SINM = 3 * MiB;
constexpr size_t WS_COSN = 5 * MiB, WS_SINN = 6 * MiB;
constexpr size_t WS_BIAS = 7 * MiB - 4096;
constexpr size_t WS_SSQX = 7 * MiB;
constexpr size_t WS_SSQ1 = 8 * MiB;
constexpr size_t WS_SSQKN = 252 * MiB;
constexpr size_t WS_KPES = 12 * MiB;
constexpr size_t WS_KCMP = 14 * MiB;
constexpr size_t WS_VCMP = 15 * MiB;
constexpr size_t WS_W = 16 * MiB;
constexpr size_t WSZ_MLA = (size_t)(2816 * 1024 + 3072 * 384 + 4096 * 256 + 1024 * 2048) * 2;
constexpr size_t WSZ_NSA = (size_t)(4608 * 1024 + 96 * 3072 + 96 * 96 + 64 * 2048 + 64 * 64 + 1024 * 1024) * 2;
constexpr size_t WS_XB = 68 * MiB;
constexpr size_t WS_P1 = 100 * MiB;
constexpr size_t WS_KVH = 188 * MiB;
static_assert(WS_W + 2 * (WSZ_MLA + WSZ_NSA) <= WS_XB, "weights fit");

struct MlaW { bf16_t *win, *wuq, *wukv, *wout; };
struct NsaW { bf16_t *win, *w1k, *w2k, *w1v, *w2v, *wout; float *bk, *bv; };
__host__ __device__ inline MlaW mla_w(unsigned char* ws, int j) {
    bf16_t* p = (bf16_t*)(ws + WS_W + (size_t)j * (WSZ_MLA + WSZ_NSA));
    MlaW w; w.win = p; w.wuq = w.win + 2816 * 1024; w.wukv = w.wuq + 3072 * 384; w.wout = w.wukv + 4096 * 256; return w;
}
__host__ __device__ inline NsaW nsa_w(unsigned char* ws, int j) {
    bf16_t* p = (bf16_t*)(ws + WS_W + (size_t)j * (WSZ_MLA + WSZ_NSA) + WSZ_MLA);
    NsaW w; w.win = p; w.w1k = w.win + 4608 * 1024; w.w2k = w.w1k + 96 * 3072; w.w1v = w.w2k + 96 * 96; w.w2v = w.w1v + 64 * 2048; w.wout = w.w2v + 64 * 64;
    w.bk = (float*)(ws + WS_BIAS) + j * 160; w.bv = w.bk + 96; return w;
}

enum { I_X = 0, I_POS, I_NORMG, I_MWIN, I_MGCQ, I_MWUQ, I_MGCKV, I_MWUKV, I_MGQ, I_MGK, I_MWOUT,
       I_NWIN, I_NGQ, I_NGK, I_NPEK, I_NW1K, I_NW2K, I_NPEV, I_NW1V, I_NW2V, I_NWOUT, N_INPUTS };

__device__ __forceinline__ float bf2f(bf16_t v) { return __uint_as_float((unsigned)v << 16); }
__device__ __forceinline__ bf16_t f2bf(float f) { unsigned u = __float_as_uint(f); return (bf16_t)((u + 0x7fffu + ((u >> 16) & 1u)) >> 16); }
template <int CTRL> __device__ __forceinline__ float dppf(float x) { return __int_as_float(__builtin_amdgcn_update_dpp(0, __float_as_int(x), CTRL, 0xf, 0xf, false)); }
__device__ __forceinline__ float get_xor1(float x) { return dppf<0xB1>(x); }
__device__ __forceinline__ float get_xor2(float x) { return dppf<0x4E>(x); }
__device__ __forceinline__ float sum_xor16(float x) { auto r = __builtin_amdgcn_permlane16_swap(__float_as_uint(x), __float_as_uint(x), false, false); return __uint_as_float(r[0]) + __uint_as_float(r[1]); }
__device__ __forceinline__ float sum_xor32(float x) { auto r = __builtin_amdgcn_permlane32_swap(__float_as_uint(x), __float_as_uint(x), false, false); return __uint_as_float(r[0]) + __uint_as_float(r[1]); }
__device__ __forceinline__ float get_xor32(float x, int hi) { auto r = __builtin_amdgcn_permlane32_swap(__float_as_uint(x), __float_as_uint(x), false, false); return __uint_as_float(hi ? r[0] : r[1]); }
__device__ __forceinline__ float wave_sum(float v) {
    v += get_xor1(v); v += get_xor2(v); v += dppf<0x124>(v); v += dppf<0x128>(v);
    return sum_xor32(sum_xor16(v));
}

__constant__ float c_invf32[32] = {1.000000000e+00f, 6.636012793e-01f, 4.403665960e-01f, 2.922278047e-01f, 1.939227432e-01f, 1.286873668e-01f, 8.539710194e-02f, 5.666962266e-02f, 3.760603070e-02f, 2.495540865e-02f, 1.656043902e-02f, 1.098952908e-02f, 7.292664610e-03f, 4.839421250e-03f, 3.211445874e-03f, 2.131119603e-03f, 1.414213562e-03f, 9.384738514e-04f, 6.227723788e-04f, 4.132725589e-04f, 2.742481884e-04f, 1.819914323e-04f, 1.207697351e-04f, 8.014294872e-05f, 5.318296098e-05f, 3.529227615e-05f, 2.341999971e-05f, 1.554154005e-05f, 1.031338616e-05f, 6.843975370e-06f, 4.541670478e-06f, 3.013858077e-06f};
__constant__ float c_invf12[12] = {1.000000000e+00f, 3.350316584e-01f, 1.122462004e-01f, 3.760603070e-02f, 1.259920839e-02f, 4.221134819e-03f, 1.414213562e-03f, 4.738064308e-04f, 1.587400620e-04f, 5.318296098e-05f, 1.781797801e-05f, 5.969583526e-06f};
#define GAS __attribute__((address_space(1)))
#define LAS __attribute__((address_space(3)))
typedef unsigned v4u __attribute__((ext_vector_type(4)));
typedef float f32x4 __attribute__((ext_vector_type(4)));
typedef short bf16x8 __attribute__((ext_vector_type(8)));
typedef GAS unsigned gu32;
typedef GAS unsigned long long gu64;
#define RLX_AGENT __ATOMIC_RELAXED, __HIP_MEMORY_SCOPE_AGENT
#define LDS_WAIT() asm volatile("s_waitcnt lgkmcnt(0)" ::: "memory")
#define VM_WAIT() asm volatile("s_waitcnt vmcnt(0)" ::: "memory")
__device__ __forceinline__ unsigned long long rt() { return __builtin_amdgcn_s_memrealtime(); }
__device__ __forceinline__ unsigned pk2(float lo, float hi) { return (unsigned)f2bf(lo) | ((unsigned)f2bf(hi) << 16); }

#define XB_TMO      128
#define XB_XCNT(j)  (256  + 64 * (j))
#define XB_XSUB(j)  (1280 + 64 * (j))
#define XB_XGEN(j)  (2304 + 64 * (j))
#define XB_TOP      3328
#define XB_TOPGEN   3392
#define XCD_BAR_WORDS 3456
#define XB_SPIN_CAP (1u << 18)

__device__ __forceinline__ unsigned xb_ld(unsigned* p)              { return __hip_atomic_load(p, __ATOMIC_RELAXED, __HIP_MEMORY_SCOPE_AGENT); }
__device__ __forceinline__ unsigned xb_add(unsigned* p, unsigned v) { return __hip_atomic_fetch_add(p, v, __ATOMIC_RELAXED, __HIP_MEMORY_SCOPE_AGENT); }
__device__ __forceinline__ unsigned xb_xcc_id() { return (unsigned)__builtin_amdgcn_s_getreg((3 << 11) | 20) & 0xFu; }
#define XB_SPIN(cond, bar) do { unsigned _sp = 0; while (cond) { __builtin_amdgcn_s_sleep(1); \
    if ((++_sp & 255u) == 0u) { if (xb_ld(&(bar)[XB_TMO])) break; if (_sp > XB_SPIN_CAP) { atomicAdd(&(bar)[XB_TMO], 1u); break; } } } } while (0)

struct XcdBarrier {
    unsigned* bar; unsigned x;
    volatile LAS unsigned* st;
};

__device__ __forceinline__ XcdBarrier xcd_barrier_post(unsigned* bar, volatile LAS unsigned* st) {
    XcdBarrier b; b.bar = bar; b.x = xb_xcc_id(); b.st = st;
    if (threadIdx.x == 0) (void)xb_add(&bar[XB_XCNT(b.x)], 1u);
    return b;
}
__device__ __forceinline__ void xcd_barrier_complete(unsigned* bar, unsigned x, unsigned& nloc, unsigned& nx) {
    const unsigned G = gridDim.x * gridDim.y * gridDim.z;
    unsigned sum, cnt, mine, sp = 0u;
    for (;;) {
        sum = 0u; cnt = 0u; mine = 0u;
#pragma unroll
        for (unsigned j = 0; j < 16; ++j) { const unsigned c = xb_ld(&bar[XB_XCNT(j)]); sum += c; cnt += (c > 0u) ? 1u : 0u; mine = (j == x) ? c : mine; }
        if (sum == G) break;
        __builtin_amdgcn_s_sleep(1);
        if ((++sp & 255u) == 0u) { if (xb_ld(&bar[XB_TMO])) break; if (sp > XB_SPIN_CAP) { atomicAdd(&bar[XB_TMO], 1u); break; } }
    }
    nloc = mine > 0u ? mine : 1u; nx = cnt > 0u ? cnt : 1u;
}

__device__ __forceinline__ void xcd_barrier(const XcdBarrier& b) {
    asm volatile("s_waitcnt vmcnt(0)" ::: "memory");
    __syncthreads();
    if (threadIdx.x == 0) {
        unsigned* bar = b.bar;
        __builtin_amdgcn_s_waitcnt(0);
        unsigned nloc = b.st[0], nx = b.st[1];
        if (nloc == 0u) { xcd_barrier_complete(bar, b.x, nloc, nx); b.st[0] = nloc; b.st[1] = nx; }
        const unsigned old = xb_add(&bar[XB_XSUB(b.x)], 1u);
        const unsigned gen = old / nloc;
        if (old + 1u == (gen + 1u) * nloc) {
            __builtin_amdgcn_fence(__ATOMIC_RELEASE, "agent");
            asm volatile("s_waitcnt vmcnt(0)" ::: "memory");
            const unsigned og = xb_add(&bar[XB_TOP], 1u);
            const unsigned tg = og / nx;
            if (og + 1u == (tg + 1u) * nx) xb_add(&bar[XB_TOPGEN], 1u);
            else XB_SPIN(xb_ld(&bar[XB_TOPGEN]) == tg, bar);
            __builtin_amdgcn_fence(__ATOMIC_ACQUIRE, "agent");
            xb_add(&bar[XB_XGEN(b.x)], 1u);
            asm volatile("s_waitcnt vmcnt(0)" ::: "memory");
        } else {
            XB_SPIN(xb_ld(&bar[XB_XGEN(b.x)]) == gen, bar);
            __builtin_amdgcn_fence(__ATOMIC_ACQUIRE, "agent");
            asm volatile("s_waitcnt vmcnt(0)" ::: "memory");
        }
    }
    __syncthreads();
}
namespace pg8 {
#define PG8_LAS __attribute__((address_space(3)))
typedef short bf16x8 __attribute__((ext_vector_type(8)));
typedef float f32x4 __attribute__((ext_vector_type(4)));
typedef unsigned u32x4 __attribute__((ext_vector_type(4)));
constexpr int BM = 256, BK = 64, HALF = 128, HTB = HALF * BK * 2  , STAGE_BYTES = 8 * HTB, NXCD = 8, WGM = 8;

__host__ __device__ __forceinline__ int lds_byte(int r, int c) { const int st = (r >> 4) * 2 + (c >> 5), rr = r & 15, cc = c & 31, ob = rr * 64 + cc * 2; return st * 1024 + (ob ^ (((ob >> 9) & 1) << 5)); }
__host__ __device__ __forceinline__ void stage_rc(int b, int& R, int& C) { const int st = b / 1024, sb = b % 1024, swz = sb ^ (((sb >> 9) & 1) << 5); R = (st >> 1) * 16 + swz / 64; C = (st & 1) * 32 + (swz % 64) / 2; }
__host__ __device__ __forceinline__ int perm32(int rho) { const int n = rho >> 4, i = rho & 15; return 8 * (i >> 2) + 4 * n + (i & 3); }

struct Unit { int pm, pn; };
struct Gemm { const bf16_t* A; const bf16_t* Bt; int M, N, K, lda; };

struct StaticOrder {
    int nM, nN, nwg, G, c;
    __host__ __device__ void init(int M, int N, int G_, int c_) { nM = M / BM; nN = N / BM; nwg = nM * nN; G = G_; c = c_; }
    __host__ __device__ bool next(int i, Unit& u) const {
        const long L = (long)i * G + c; if (L >= nwg) return false;
        int wgid = (int)L; { const int q = nwg / NXCD, r = nwg % NXCD, xcd = wgid % NXCD, off = wgid / NXCD; wgid = (xcd < r ? xcd * (q + 1) : r * (q + 1) + (xcd - r) * q) + off; }
        const int nig = WGM * nN, gid = wgid / nig, fm = gid * WGM, gsz = (nM - fm) < WGM ? (nM - fm) : WGM;
        u.pm = fm + ((wgid % nig) % gsz); u.pn = (wgid % nig) / gsz; return true;
    }
    __device__ __forceinline__ void a_ready(const Unit&, int) const {}
    __device__ __forceinline__ void done(const Unit&) const {}
};

template <class Epi, class Sched, bool ALIGN_EPI = false, bool SP2 = false>
__device__ __forceinline__ void gemm_phase(PG8_LAS unsigned char* lds, const Gemm g, const Sched& S, const Epi& E) {
    int tid_ = threadIdx.x; asm volatile("" : "+v"(tid_));
    const int tid = tid_, wid = __builtin_amdgcn_readfirstlane(tid >> 6), lane = tid & 63, wr = wid >> 2, wc = wid & 3, fr = lane & 15, fq = lane >> 4;
    const int K = g.K, nt = K / BK;
    unsigned voffA[2], voffB[2];
#pragma unroll
    for (int i = 0; i < 2; ++i) { int R, C; stage_rc(tid * 16 + i * 8192, R, C); const int Rb = Epi::PERM ? ((R & ~31) + perm32(R & 31)) : R;
        voffA[i] = (unsigned)(R * g.lda + C) * 2u; voffB[i] = (unsigned)(Rb * K + C) * 2u; }
    const size_t kstep = (size_t)(BK * 2);
    const size_t hstepA = (size_t)HALF * g.lda * 2, hstepB = (size_t)HALF * K * 2;
    const size_t tstepA = 2 * hstepA, tstepB = 2 * hstepB;
    const unsigned ldsw = (unsigned)wid * 1024u;
    const int aoff = lds_byte(wr * 64 + fr, fq * 8), boff = lds_byte(wc * 32 + fr, fq * 8);
#define PG8_SA(b, h) (((b) * 2 + (h)) * HTB)
#define PG8_SB(b, h) ((4 + (b) * 2 + (h)) * HTB)
#define PG8_STAGE(bufoff, gbase, voff) do { _Pragma("unroll") for (int _i = 0; _i < 2; ++_i) \
        __builtin_amdgcn_global_load_lds((const unsigned*)((const char*)(gbase) + (voff)[_i]), (PG8_LAS unsigned*)(lds + (bufoff) + ldsw + _i * 8192), 16, 0, 0); } while (0)
#define PG8_LDA(dst, b, h) do { _Pragma("unroll") for (int m = 0; m < 4; ++m) _Pragma("unroll") for (int k = 0; k < 2; ++k) dst[m][k] = *(const PG8_LAS bf16x8*)(lds + PG8_SA(b, h) + aoff + m * 2048 + k * 1024); } while (0)
#define PG8_LDB(dst, b, h) do { _Pragma("unroll") for (int n = 0; n < 2; ++n) _Pragma("unroll") for (int k = 0; k < 2; ++k) dst[n][k] = *(const PG8_LAS bf16x8*)(lds + PG8_SB(b, h) + boff + n * 2048 + k * 1024); } while (0)
#define PG8_MMA(ai, bj, At, Bt) do { __builtin_amdgcn_s_setprio(1); _Pragma("unroll") for (int m = 0; m < 4; ++m) _Pragma("unroll") for (int n = 0; n < 2; ++n) _Pragma("unroll") for (int k = 0; k < 2; ++k) \
        acc[ai][bj][m][n] = __builtin_amdgcn_mfma_f32_16x16x32_bf16(Bt[n][k], At[m][k], acc[ai][bj][m][n], 0, 0, 0); __builtin_amdgcn_s_setprio(0); } while (0)
#define PG8_WAIT_V(n) asm volatile("s_waitcnt vmcnt(" #n ")" ::: "memory")
#define PG8_WAIT_L(n) asm volatile("s_waitcnt lgkmcnt(" #n ")" ::: "memory")
#define PG8_BAR __builtin_amdgcn_s_barrier()
#define PG8_SCHED __builtin_amdgcn_sched_barrier(0)
    Unit cur, nxt; int ui = 0;
    if (!S.next(0, cur)) return;
    f32x4 acc[2][2][4][2];
#pragma unroll
    for (int a = 0; a < 2; ++a)
#pragma unroll
        for (int b = 0; b < 2; ++b)
#pragma unroll
            for (int m = 0; m < 4; ++m)
#pragma unroll
                for (int n = 0; n < 2; ++n) acc[a][b][m][n] = (f32x4){0.f, 0.f, 0.f, 0.f};
    bf16x8 At[4][2], B0[2][2], B1[2][2];
    const char* cA = (const char*)g.A + (size_t)cur.pm * tstepA; const char* cB = (const char*)g.Bt + (size_t)cur.pn * tstepB;
    S.a_ready(cur, ui);
    if constexpr (SP2) {
        PG8_STAGE(PG8_SB(0, 0), cB, voffB); PG8_STAGE(PG8_SB(0, 1), cB + hstepB, voffB); PG8_STAGE(PG8_SA(0, 0), cA, voffA); PG8_STAGE(PG8_SA(0, 1), cA + hstepA, voffA);
        if (wr == 1) PG8_BAR;
        PG8_WAIT_V(2); PG8_BAR;
        PG8_STAGE(PG8_SB(1, 0), cB + kstep, voffB); PG8_STAGE(PG8_SA(1, 0), cA + kstep, voffA); PG8_STAGE(PG8_SB(1, 1), cB + hstepB + kstep, voffB);
        PG8_WAIT_V(6); PG8_BAR;
    } else {
        PG8_STAGE(PG8_SB(0, 0), cB, voffB); PG8_STAGE(PG8_SA(0, 0), cA, voffA); PG8_STAGE(PG8_SB(0, 1), cB + hstepB, voffB); PG8_STAGE(PG8_SA(0, 1), cA + hstepA, voffA);
        if (wr == 1) PG8_BAR;
        PG8_WAIT_V(4); PG8_BAR;
        PG8_STAGE(PG8_SB(1, 0), cB + kstep, voffB); PG8_STAGE(PG8_SA(1, 0), cA + kstep, voffA); PG8_STAGE(PG8_SB(1, 1), cB + hstepB + kstep, voffB);
        PG8_WAIT_V(6); PG8_BAR;
    }
    for (;;) {
        const bool has_next = S.next(ui + 1, nxt);
        const char* nA = has_next ? (const char*)g.A + (size_t)nxt.pm * tstepA : cA; const char* nB = has_next ? (const char*)g.Bt + (size_t)nxt.pn * tstepB : cB;
        for (int t = 0; t < nt; t += 2) {
            const bool last = (t == nt - 2);
            const char* a1 = cA + (size_t)(t + 1) * kstep;
            const char* a2 = last ? nA : cA + (size_t)(t + 2) * kstep; const char* b2 = last ? nB : cB + (size_t)(t + 2) * kstep;
            const char* a3 = a2 + kstep; const char* b3 = b2 + kstep;
            if (last && has_next) S.a_ready(nxt, ui + 1);
            if constexpr (SP2) {
            PG8_LDB(B0, 0, 0); PG8_LDB(B1, 0, 1); PG8_SCHED; PG8_LDA(At, 0, 0); PG8_STAGE(PG8_SA(1, 1), a1 + hstepA, voffA);
            PG8_WAIT_V(8); PG8_WAIT_L(0); PG8_BAR; PG8_MMA(0, 0, At, B0); PG8_MMA(0, 1, At, B1); PG8_BAR; PG8_SCHED;
            PG8_LDA(At, 0, 1); PG8_STAGE(PG8_SB(0, 0), b2, voffB); PG8_STAGE(PG8_SB(0, 1), b2 + hstepB, voffB); PG8_STAGE(PG8_SA(0, 0), a2, voffA);
            PG8_WAIT_V(8); PG8_WAIT_L(0); PG8_BAR; PG8_MMA(1, 0, At, B0); PG8_MMA(1, 1, At, B1); PG8_BAR; PG8_SCHED;
            PG8_LDB(B0, 1, 0); PG8_LDB(B1, 1, 1); PG8_SCHED; PG8_LDA(At, 1, 0); PG8_STAGE(PG8_SA(0, 1), a2 + hstepA, voffA);
            PG8_WAIT_V(8); PG8_WAIT_L(0); PG8_BAR; PG8_MMA(0, 0, At, B0); PG8_MMA(0, 1, At, B1); PG8_BAR; PG8_SCHED;
            PG8_LDA(At, 1, 1); PG8_STAGE(PG8_SB(1, 0), b3, voffB); PG8_STAGE(PG8_SB(1, 1), b3 + hstepB, voffB); PG8_STAGE(PG8_SA(1, 0), a3, voffA);
            PG8_WAIT_V(8); PG8_WAIT_L(0); PG8_BAR; PG8_MMA(1, 0, At, B0); PG8_MMA(1, 1, At, B1); PG8_BAR; PG8_SCHED;
            } else {
            PG8_LDB(B0, 0, 0); PG8_SCHED; PG8_LDA(At, 0, 0); PG8_STAGE(PG8_SA(1, 1), a1 + hstepA, voffA);
            PG8_WAIT_L(8); PG8_BAR; PG8_WAIT_L(0); PG8_MMA(0, 0, At, B0); PG8_BAR; PG8_SCHED;
            PG8_LDB(B1, 0, 1); PG8_STAGE(PG8_SB(0, 0), b2, voffB);
            PG8_BAR; PG8_WAIT_L(0); PG8_MMA(0, 1, At, B1); PG8_BAR;
            PG8_LDA(At, 0, 1); PG8_STAGE(PG8_SA(0, 0), a2, voffA);
            PG8_BAR; PG8_WAIT_L(0); PG8_MMA(1, 0, At, B0); PG8_BAR; PG8_SCHED;
            PG8_STAGE(PG8_SB(0, 1), b2 + hstepB, voffB);
            PG8_WAIT_V(6); PG8_BAR; PG8_MMA(1, 1, At, B1); PG8_BAR;
            PG8_LDB(B0, 1, 0); PG8_SCHED; PG8_LDA(At, 1, 0); PG8_STAGE(PG8_SA(0, 1), a2 + hstepA, voffA);
            PG8_WAIT_L(8); PG8_BAR; PG8_WAIT_L(0); PG8_MMA(0, 0, At, B0); PG8_BAR; PG8_SCHED;
            PG8_LDB(B1, 1, 1); PG8_STAGE(PG8_SB(1, 0), b3, voffB);
            PG8_BAR; PG8_WAIT_L(0); PG8_MMA(0, 1, At, B1); PG8_BAR;
            PG8_LDA(At, 1, 1); PG8_STAGE(PG8_SA(1, 0), a3, voffA);
            PG8_BAR; PG8_WAIT_L(0); PG8_MMA(1, 0, At, B0); PG8_BAR; PG8_SCHED;
            PG8_STAGE(PG8_SB(1, 1), b3 + hstepB, voffB);
            PG8_WAIT_V(6); PG8_BAR; PG8_MMA(1, 1, At, B1); PG8_BAR;
            }
        }
        if constexpr (ALIGN_EPI) { if (wr == 0) PG8_BAR; }
        if constexpr (!Epi::AFTER_DRAIN) { E(acc, cur, wr, wc, fr, fq, ui); S.done(cur); }
        if (!has_next) break;
#pragma unroll
        for (int a = 0; a < 2; ++a)
#pragma unroll
            for (int b = 0; b < 2; ++b)
#pragma unroll
                for (int m = 0; m < 4; ++m)
#pragma unroll
                    for (int n = 0; n < 2; ++n) acc[a][b][m][n] = (f32x4){0.f, 0.f, 0.f, 0.f};
        cur = nxt; cA = nA; cB = nB; ++ui;
        if constexpr (ALIGN_EPI) { if (wr == 1) PG8_BAR; }
    }
    PG8_WAIT_V(0);
    if constexpr (!ALIGN_EPI) { if (wr == 0) PG8_BAR; }
    PG8_BAR;
    if constexpr (Epi::AFTER_DRAIN) { E.fused(acc, cur, wr, wc, fr, fq, lds, wid, lane); S.done(cur); }
#undef PG8_SA
#undef PG8_SB
#undef PG8_STAGE
#undef PG8_LDA
#undef PG8_LDB
#undef PG8_MMA
#undef PG8_WAIT_V
#undef PG8_WAIT_L
#undef PG8_BAR
#undef PG8_SCHED
}
}
namespace pg8 {
__device__ __forceinline__ unsigned cvt_pk_bf16(float lo, float hi) { unsigned r; asm volatile("v_cvt_pk_bf16_f32 %0, %1, %2" : "=v"(r) : "v"(lo), "v"(hi)); return r; }

constexpr int RS_LDS_OFF = STAGE_BYTES, RS_LDS_BUF = 8192;
struct OrderRS : StaticOrder {
    const float* rs_ssq; int rs_nslot; PG8_LAS unsigned char* lds;
    __device__ __forceinline__ void a_ready(const Unit& u, int ui) const {
        const int wid = __builtin_amdgcn_readfirstlane(threadIdx.x >> 6), lane = threadIdx.x & 63;
        for (int i = wid; i < rs_nslot * 4; i += 8) { const int slot = i >> 2, rb = i & 3;
            __builtin_amdgcn_global_load_lds((const unsigned*)(rs_ssq + (size_t)slot * T + u.pm * BM + rb * 64 + lane),
                                             (PG8_LAS unsigned*)(lds + RS_LDS_OFF + (ui & 1) * RS_LDS_BUF + slot * 1024 + rb * 256), 4, 0, 0); }
    }
};
struct EpiBf16RS {
    static constexpr bool PERM = true, AFTER_DRAIN = false;
    bf16_t* O; int ldc;
    const float* rs_ssq; int rs_nslot; float rs_invn;
    int skip;
    float* ssq_out; int ssq_mode;
    PG8_LAS unsigned char* lds;
    bf16_t* O2; int split_pn;
    __device__ __forceinline__ void operator()(const f32x4 (&acc)[2][2][4][2], const Unit& u, int wr, int wc, int fr, int fq, int ui) const {
        if (skip == 1) return;
        const int row0 = u.pm * BM + wr * 64 + fr, col0 = u.pn * BM + wc * 32 + 8 * fq;
        float scs[2][4];
#pragma unroll
        for (int ai = 0; ai < 2; ++ai)
#pragma unroll
            for (int m = 0; m < 4; ++m) { float s = 0.f;
                if (rs_nslot && skip != 3) { const PG8_LAS float* rp = (const PG8_LAS float*)(lds + RS_LDS_OFF + (ui & 1) * RS_LDS_BUF) + wr * 64 + fr + ai * HALF + m * 16;
#pragma unroll
                    for (int i = 0; i < 8; ++i) if (i < rs_nslot) s += rp[i * 256]; }
                scs[ai][m] = s; }
#pragma unroll
        for (int ai = 0; ai < 2; ++ai)
#pragma unroll
            for (int m = 0; m < 4; ++m) {
                const int row = row0 + ai * HALF + m * 16;
                const float sc = rs_nslot ? rsqrtf(scs[ai][m] * rs_invn + EPS) : 1.f;
                bf16_t* rowp = (split_pn > 0 && u.pn >= split_pn) ? O2 + (size_t)row * ldc + (col0 - split_pn * BM) : O + (size_t)row * ldc + col0;
#pragma unroll
                for (int bj = 0; bj < 2; ++bj) {
                    const f32x4 v0 = acc[ai][bj][m][0] * sc, v1 = acc[ai][bj][m][1] * sc;
                    u32x4 w; w.x = cvt_pk_bf16(v0[0], v0[1]); w.y = cvt_pk_bf16(v0[2], v0[3]); w.z = cvt_pk_bf16(v1[0], v1[1]); w.w = cvt_pk_bf16(v1[2], v1[3]);
                    if (skip != 2) *(u32x4*)(rowp + bj * HALF) = w; else asm volatile("" :: "v"(w));
                    const bool do_ssq = ssq_mode == 2 ? (bj == 0) : (ssq_mode == 1 && 8 * u.pn + 4 * bj + wc < 22);
                    if (do_ssq) {
                        float q = (v0[0] * v0[0] + v0[1] * v0[1]) + (v0[2] * v0[2] + v0[3] * v0[3]) + (v1[0] * v1[0] + v1[1] * v1[1]) + (v1[2] * v1[2] + v1[3] * v1[3]);
                        q = sum_xor32(sum_xor16(q));
                        if (fq == 0) {
                            if (ssq_mode == 1) ssq_out[(size_t)(8 * u.pn + 4 * bj + wc) * T + row] = q;
                            else ssq_out[(size_t)(u.pn * 4 + wc) * T + row] = q;
                        }
                    }
                }
            }
    }
};

struct EpiResid {
    static constexpr bool PERM = false, AFTER_DRAIN = true;
    const float* xf; bf16_t* xb; float* outf; float* ssqx; int dry;
    __device__ __forceinline__ void fused(f32x4 (&acc)[2][2][4][2], const Unit& u, int wr, int wc, int fr, int fq, PG8_LAS unsigned char* lds, int wid, int lane) const {
        typedef unsigned u32x2v __attribute__((ext_vector_type(2)));
        PG8_LAS float* P = (PG8_LAS float*)lds;
        const int col0 = u.pn * BM + wc * 32 + 4 * fq;
#pragma unroll
        for (int ai = 0; ai < 2; ++ai) {
            f32x4 res[4][2][2];
#pragma unroll
            for (int m = 0; m < 4; ++m) { const size_t rowoff = (size_t)(u.pm * BM + ai * HALF + wr * 64 + m * 16 + fr) * DM + col0;
#pragma unroll
                for (int bj = 0; bj < 2; ++bj)
#pragma unroll
                    for (int n = 0; n < 2; ++n) { const size_t off = rowoff + bj * HALF + n * 16;
                        if (xf) res[m][bj][n] = *(const f32x4*)(xf + off);
                        else { const u32x2v w = *(const u32x2v*)(xb + off); res[m][bj][n] = (f32x4){__uint_as_float(w.x << 16), __uint_as_float(w.x & 0xffff0000u), __uint_as_float(w.y << 16), __uint_as_float(w.y & 0xffff0000u)}; } } }
#pragma unroll
            for (int m = 0; m < 4; ++m) {
                const int r = ai * HALF + wr * 64 + m * 16 + fr; const size_t rowoff = (size_t)(u.pm * BM + r) * DM + col0; float q = 0.f;
#pragma unroll
                for (int bj = 0; bj < 2; ++bj)
#pragma unroll
                    for (int n = 0; n < 2; ++n) {
                        const size_t off = rowoff + bj * HALF + n * 16;
                        const f32x4 v = res[m][bj][n] + acc[ai][bj][m][n];
                        if (dry) { q += v[0]; } else if (outf) *(f32x4*)(outf + off) = v;
                        else { u32x2v w; w.x = cvt_pk_bf16(v[0], v[1]); w.y = cvt_pk_bf16(v[2], v[3]); *(u32x2v*)(xb + off) = w;
                               const float a = __uint_as_float(w.x << 16), b = __uint_as_float(w.x & 0xffff0000u), c = __uint_as_float(w.y << 16), d = __uint_as_float(w.y & 0xffff0000u);
                               q += (a * a + b * b) + (c * c + d * d); }
                    }
                if (!outf) { q = sum_xor32(sum_xor16(q)); if (fq == 0) P[r * 4 + wc] = q; }
            }
        }
        if (!outf && !dry) {
            __syncthreads();
            const int t = wid * 64 + lane;
            if (t < 256) ssqx[(size_t)u.pn * T + u.pm * BM + t] = (P[t * 4 + 0] + P[t * 4 + 1]) + (P[t * 4 + 2] + P[t * 4 + 3]);
        }
    }
};
}
constexpr int NWAVES = 8;
constexpr int GRID = 256;
constexpr int LDS_BYTES = 163840;
constexpr int LDSCTL_OFF = 0, MISC_OFF = 320;
constexpr int RING_OFF = 512, RING_BYTES = LDS_BYTES - RING_OFF;
constexpr int CW_BAR = 4096;
constexpr int N_PHASES = 17;

enum PhaseKind { K_PROLOGUE = 0, K_MLA_G1, K_MLA_G2, K_MLA_ATT, K_OUT, K_NSA_G1, K_NSA_POST, K_NSA_ATT };
struct PhaseDesc { int kind, j, half, L; };
__host__ __device__ inline PhaseDesc decode_phase(int ph) {
    PhaseDesc d{K_PROLOGUE, 0, 0, 0}; if (ph == 0) return d;
    const int p = ph - 1; d.j = p / 8; const int r = p % 8;
    if (r < 4) { d.L = 2 * d.j; d.kind = r == 0 ? K_MLA_G1 : r == 1 ? K_MLA_G2 : r == 2 ? K_MLA_ATT : K_OUT; }
    else { d.L = 2 * d.j + 1; const int q = r - 4; d.kind = q == 0 ? K_NSA_G1 : q == 1 ? K_NSA_POST : q == 2 ? K_NSA_ATT : K_OUT; }
    return d;
}

struct Args { const void* in[N_INPUTS]; float* out; unsigned char* ws; int ph_lo, ph_hi, dry, pad; };

struct Frame {
    LAS unsigned char* lds; int tid, lane, wave, G;
    const void* const* in; float* out; unsigned char* ws;
    __device__ __forceinline__ const float* f(int i) const { return (const float*)in[i]; }
    __device__ __forceinline__ bf16_t* xb() const { return (bf16_t*)(ws + WS_XB); }
    __device__ __forceinline__ bf16_t* p1() const { return (bf16_t*)(ws + WS_P1); }
    __device__ __forceinline__ bf16_t* kvh() const { return (bf16_t*)(ws + WS_KVH); }
    __device__ __forceinline__ bf16_t* kvh2() const { return (bf16_t*)out; }
    __device__ __forceinline__ bf16_t* kpes() const { return (bf16_t*)(ws + WS_KPES); }
    __device__ __forceinline__ bf16_t* kcmp() const { return (bf16_t*)(ws + WS_KCMP); }
    __device__ __forceinline__ bf16_t* vcmp() const { return (bf16_t*)(ws + WS_VCMP); }
    __device__ __forceinline__ float* ssqx() const { return (float*)(ws + WS_SSQX); }
    __device__ __forceinline__ float* ssq1() const { return (float*)(ws + WS_SSQ1); }
    __device__ __forceinline__ float* ssqkn() const { return (float*)(ws + WS_SSQKN); }
    __device__ __forceinline__ float* cosM() const { return (float*)(ws + WS_COSM); }
    __device__ __forceinline__ float* sinM() const { return (float*)(ws + WS_SINM); }
    __device__ __forceinline__ float* cosN() const { return (float*)(ws + WS_COSN); }
    __device__ __forceinline__ float* sinN() const { return (float*)(ws + WS_SINN); }
};

__device__ __forceinline__ void phase_kpes(Frame& F, int j) {
    const bf16_t* p1 = F.p1(); const float* gk = F.f(I_MGK) + j * 192; const float* cosM = F.cosM(); const float* sinM = F.sinM(); bf16_t* kpes = F.kpes();
    constexpr int NTH = GRID * NWAVES * 64;
    float av[4], bv[4], cv[4], sv[4];
#pragma unroll
    for (int u = 0; u < 4; ++u) { const int i = blockIdx.x * (NWAVES * 64) + F.tid + u * NTH; const int t = i >> 5, f = i & 31;
        av[u] = bf2f(p1[(size_t)t * M_INP + M_KPE + f]) * gk[f]; bv[u] = bf2f(p1[(size_t)t * M_INP + M_KPE + 32 + f]) * gk[32 + f]; cv[u] = cosM[i]; sv[u] = sinM[i]; }
#pragma unroll
    for (int u = 0; u < 4; ++u) { const int i = blockIdx.x * (NWAVES * 64) + F.tid + u * NTH; const int t = i >> 5, f = i & 31;
        kpes[(size_t)t * 64 + f] = f2bf(av[u] * cv[u] - bv[u] * sv[u]); kpes[(size_t)t * 64 + 32 + f] = f2bf(bv[u] * cv[u] + av[u] * sv[u]); }
}
namespace pro {
__device__ __forceinline__ void sincos_rev(float ang, float& s, float& c) {
    double r = (double)ang * 0.15915494309189535; r -= floor(r);
    const float fr = (float)r; s = __builtin_amdgcn_sinf(fr); c = __builtin_amdgcn_cosf(fr);
}
__device__ __forceinline__ void transpose_item(const float* __restrict__ W, const float* __restrict__ g, bf16_t* __restrict__ WT, int K, int N, int Npad, LAS float* scr, int item, int lane) {
    const int nblk = Npad / 32, kb = item / nblk, nb = item - kb * nblk, k0 = 64 * kb, n0 = 32 * nb;
    float v[32];
#pragma unroll
    for (int i = 0; i < 32; ++i) { const int k = k0 + 2 * i + (lane >> 5), n = n0 + (lane & 31); v[i] = (k < K && n < N) ? W[(size_t)k * N + n] : 0.f; }
    if (g) {
#pragma unroll
        for (int i = 0; i < 32; ++i) { const int k = k0 + 2 * i + (lane >> 5); v[i] *= (k < K) ? g[k] : 0.f; } }
#pragma unroll
    for (int i = 0; i < 32; ++i) scr[(2 * i + (lane >> 5)) * 33 + (lane & 31)] = v[i];
    LDS_WAIT(); asm volatile("" ::: "memory");
    const int c = lane & 7;
    if (k0 + 8 * c < K) {
#pragma unroll
        for (int jj = 0; jj < 4; ++jj) { const int n = (lane >> 3) + 8 * jj; const LAS float* s = scr + (8 * c) * 33 + n;
            v4u o; o.x = pk2(s[0 * 33], s[1 * 33]); o.y = pk2(s[2 * 33], s[3 * 33]); o.z = pk2(s[4 * 33], s[5 * 33]); o.w = pk2(s[6 * 33], s[7 * 33]);
            *(v4u*)(WT + (size_t)(n0 + n) * K + k0 + 8 * c) = o; } }
    LDS_WAIT(); asm volatile("" ::: "memory");
}
struct TDesc { const float* W; const float* g; bf16_t* WT; int K, N, Npad; };
__device__ __forceinline__ TDesc tdesc(Frame& F, int m) {
    const int j = m / 10, i = m % 10; const MlaW mw = mla_w(F.ws, j); const NsaW nw = nsa_w(F.ws, j);
    switch (i) {
    case 0: return TDesc{F.f(I_MWIN) + (size_t)j * 1024 * M_IN, F.f(I_NORMG) + (2 * j) * DM, mw.win, 1024, M_IN, M_INP};
    case 1: return TDesc{F.f(I_MWUQ) + (size_t)j * 384 * 3072, F.f(I_MGCQ) + j * 384, mw.wuq, 384, 3072, 3072};
    case 2: return TDesc{F.f(I_MWUKV) + (size_t)j * 256 * 4096, F.f(I_MGCKV) + j * 256, mw.wukv, 256, 4096, 4096};
    case 3: return TDesc{F.f(I_MWOUT) + (size_t)j * 2048 * 1024, nullptr, mw.wout, 2048, 1024, 1024};
    case 4: return TDesc{F.f(I_NWIN) + (size_t)j * 1024 * N_IN, F.f(I_NORMG) + (2 * j + 1) * DM, nw.win, 1024, N_IN, N_INP};
    case 5: return TDesc{F.f(I_NW1K) + (size_t)j * 3072 * 96, nullptr, nw.w1k, 3072, 96, 96};
    case 6: return TDesc{F.f(I_NW2K) + (size_t)j * 96 * 96, nullptr, nw.w2k, 96, 96, 96};
    case 7: return TDesc{F.f(I_NW1V) + (size_t)j * 2048 * 64, nullptr, nw.w1v, 2048, 64, 64};
    case 8: return TDesc{F.f(I_NW2V) + (size_t)j * 64 * 64, nullptr, nw.w2v, 64, 64, 64};
    default: return TDesc{F.f(I_NWOUT) + (size_t)j * 1024 * 1024, nullptr, nw.wout, 1024, 1024, 1024};
    }
}
__device__ __forceinline__ void phase_prologue(Frame& F) {
    const int tid = F.tid, lane = tid & 63, wid = __builtin_amdgcn_readfirstlane(tid >> 6);
    const int gw = blockIdx.x * NWAVES + wid, NGW = GRID * NWAVES;
    LAS float* scr = (LAS float*)(F.lds + RING_OFF + wid * 16384);
    { const float* x = F.f(I_X); bf16_t* xb = F.xb(); float* ssqx = F.ssqx();
      for (int m0 = 2 * gw; m0 < T; m0 += 2 * NGW) { f32x4 v[2][4];
#pragma unroll
          for (int rr = 0; rr < 2; ++rr)
#pragma unroll
              for (int jj = 0; jj < 4; ++jj) v[rr][jj] = ((const f32x4*)(x + (size_t)(m0 + rr) * DM) + lane)[64 * jj];
#pragma unroll
          for (int rr = 0; rr < 2; ++rr) { const int m = m0 + rr; unsigned long long* o8 = (unsigned long long*)(xb + (size_t)m * DM) + lane; float s = 0.f;
#pragma unroll
              for (int jj = 0; jj < 4; ++jj) { const f32x4 w = v[rr][jj]; const unsigned lo = pk2(w.x, w.y), hi2 = pk2(w.z, w.w); o8[64 * jj] = (unsigned long long)lo | ((unsigned long long)hi2 << 32);
                  const float a = __uint_as_float(lo << 16), b = __uint_as_float(lo & 0xffff0000u), c = __uint_as_float(hi2 << 16), d = __uint_as_float(hi2 & 0xffff0000u); s += (a * a + b * b) + (c * c + d * d); }
              s = wave_sum(s);
              if (lane == 0) { ssqx[m] = s; ssqx[T + m] = 0.f; ssqx[2 * T + m] = 0.f; ssqx[3 * T + m] = 0.f; } } } }
    { int cum = 0, next = gw;
      for (int m = 0; m < 20; ++m) { const TDesc d = tdesc(F, m); const int items = ((d.K + 63) / 64) * (d.Npad / 32);
          for (; next < cum + items; next += NGW) transpose_item(d.W, d.g, d.WT, d.K, d.N, d.Npad, scr, next - cum, lane);
          cum += items; } }
    { const int* pos = (const int*)F.in[I_POS]; float* cM = F.cosM(); float* sM = F.sinM(); float* cN = F.cosN(); float* sN = F.sinN();
      for (int i = blockIdx.x * (NWAVES * 64) + tid; i < T * 32; i += GRID * NWAVES * 64) { const int t = i >> 5, f = i & 31; float s, c; sincos_rev((float)pos[t] * c_invf32[f], s, c); cM[i] = c; sM[i] = s; }
      for (int i = blockIdx.x * (NWAVES * 64) + tid; i < T * 12; i += GRID * NWAVES * 64) { const int t = i / 12, f = i - t * 12; float s, c; sincos_rev((float)pos[t] * c_invf12[f], s, c); cN[i] = c; sN[i] = s; } }
}
}
namespace att {
typedef short bf16x8 __attribute__((ext_vector_type(8)));
typedef short s16x4 __attribute__((ext_vector_type(4)));
typedef float f32x16 __attribute__((ext_vector_type(16)));
typedef float f32x4 __attribute__((ext_vector_type(4)));
typedef unsigned u32x4 __attribute__((ext_vector_type(4)));
#define SBAR() __builtin_amdgcn_sched_barrier(0)
__device__ __forceinline__ int crow(int r, int hi) { return (r & 3) + 8 * (r >> 2) + 4 * hi; }
__device__ __forceinline__ unsigned cvtpk(float lo, float hi) { unsigned r; asm volatile("v_cvt_pk_bf16_f32 %0, %1, %2" : "=v"(r) : "v"(lo), "v"(hi)); return r; }
__device__ __forceinline__ bf16x8 pack8(f32x4 a, f32x4 b) { u32x4 w = {cvtpk(a[0], a[1]), cvtpk(a[2], a[3]), cvtpk(b[0], b[1]), cvtpk(b[2], b[3])}; return __builtin_bit_cast(bf16x8, w); }
__device__ __forceinline__ void unpack8(u32x4 w, float* f) {
    f[0] = __uint_as_float(w.x << 16); f[1] = __uint_as_float(w.x & 0xffff0000u); f[2] = __uint_as_float(w.y << 16); f[3] = __uint_as_float(w.y & 0xffff0000u);
    f[4] = __uint_as_float(w.z << 16); f[5] = __uint_as_float(w.z & 0xffff0000u); f[6] = __uint_as_float(w.w << 16); f[7] = __uint_as_float(w.w & 0xffff0000u);
}
template <int NB32> __device__ __forceinline__ int v_st(int k, int c) { const int kk = (k & ~0xC) | ((k & 4) << 1) | ((k & 8) >> 1); return ((kk >> 3) * NB32 + (c >> 5)) * 512 + ((kk & 7) * 32 + (c & 31)) * 2; }
__device__ __forceinline__ int v_rd_base(int lane) { return ((lane & 3) << 3) | (((lane >> 2) & 3) << 6) | (((lane >> 4) & 1) << 5) | (((lane >> 5) & 1) << 8); }
__device__ __forceinline__ void softmax_tile(f32x16& p0, f32x16& p1, float& m_reg, float& l_reg, float& alpha, bf16x8& pa0, bf16x8& pa1, bf16x8& pa2, bf16x8& pa3) {
    float pmax = p0[0];
#pragma unroll
    for (int r = 1; r < 16; ++r) pmax = fmaxf(pmax, p0[r]);
#pragma unroll
    for (int r = 0; r < 16; ++r) pmax = fmaxf(pmax, p1[r]);
    { auto rr = __builtin_amdgcn_permlane32_swap(__float_as_uint(pmax), __float_as_uint(pmax), false, false); pmax = fmaxf(__uint_as_float(rr[0]), __uint_as_float(rr[1])); }
    const float mn = fmaxf(m_reg, pmax);
    alpha = __builtin_amdgcn_exp2f(m_reg - mn); m_reg = mn;
    float ps = 0.f;
#pragma unroll
    for (int r = 0; r < 16; ++r) { p0[r] = __builtin_amdgcn_exp2f(p0[r] - mn); ps += p0[r]; }
#pragma unroll
    for (int r = 0; r < 16; ++r) { p1[r] = __builtin_amdgcn_exp2f(p1[r] - mn); ps += p1[r]; }
    { auto rr = __builtin_amdgcn_permlane32_swap(__float_as_uint(ps), __float_as_uint(ps), false, false); ps = __uint_as_float(rr[0]) + __uint_as_float(rr[1]); }
    l_reg = l_reg * alpha + ps;
#define ATT_PK4(P, B_, OUT) do { unsigned a0 = cvtpk(P[B_ + 0], P[B_ + 1]), a1 = cvtpk(P[B_ + 2], P[B_ + 3]); unsigned b0 = cvtpk(P[B_ + 4], P[B_ + 5]), b1 = cvtpk(P[B_ + 6], P[B_ + 7]); \
        auto r0 = __builtin_amdgcn_permlane32_swap(a0, b0, false, false); auto r1 = __builtin_amdgcn_permlane32_swap(a1, b1, false, false); \
        u32x4 w = {r0[0], r1[0], r0[1], r1[1]}; OUT = __builtin_bit_cast(bf16x8, w); } while (0)
    ATT_PK4(p0, 0, pa0); ATT_PK4(p0, 8, pa1); ATT_PK4(p1, 0, pa2); ATT_PK4(p1, 8, pa3);
}
template <int NB32, int VOFF> __device__ __forceinline__ void pv_tile(f32x16* o, int vb, bf16x8 pa0, bf16x8 pa1, bf16x8 pa2, bf16x8 pa3) {
#define TRRD(dst, off) asm volatile("ds_read_b64_tr_b16 %0, %1 offset:%2" : "=&v"(dst) : "v"(vb), "i"(off) : "memory")
#pragma unroll
    for (int d0 = 0; d0 < NB32; ++d0) {
        s16x4 l0, l1, l2, l3, h0, h1, h2, h3; constexpr int KS = NB32 * 1024, HF = NB32 * 512;
#define TRR(dst, ks, hf) do { if (d0 == 0) TRRD(dst, VOFF + 0 * 512 + (ks) * KS + (hf) * HF); else if (d0 == 1) TRRD(dst, VOFF + 1 * 512 + (ks) * KS + (hf) * HF); \
                              else if (d0 == 2) TRRD(dst, VOFF + 2 * 512 + (ks) * KS + (hf) * HF); else TRRD(dst, VOFF + 3 * 512 + (ks) * KS + (hf) * HF); } while (0)
        TRR(l0, 0, 0); TRR(h0, 0, 1); TRR(l1, 1, 0); TRR(h1, 1, 1); TRR(l2, 2, 0); TRR(h2, 2, 1); TRR(l3, 3, 0); TRR(h3, 3, 1);
        asm volatile("s_waitcnt lgkmcnt(0)" ::: "memory"); SBAR();
        o[d0] = __builtin_amdgcn_mfma_f32_32x32x16_bf16(pa0, (bf16x8){l0[0], l0[1], l0[2], l0[3], h0[0], h0[1], h0[2], h0[3]}, o[d0], 0, 0, 0);
        o[d0] = __builtin_amdgcn_mfma_f32_32x32x16_bf16(pa1, (bf16x8){l1[0], l1[1], l1[2], l1[3], h1[0], h1[1], h1[2], h1[3]}, o[d0], 0, 0, 0);
        o[d0] = __builtin_amdgcn_mfma_f32_32x32x16_bf16(pa2, (bf16x8){l2[0], l2[1], l2[2], l2[3], h2[0], h2[1], h2[2], h2[3]}, o[d0], 0, 0, 0);
        o[d0] = __builtin_amdgcn_mfma_f32_32x32x16_bf16(pa3, (bf16x8){l3[0], l3[1], l3[2], l3[3], h3[0], h3[1], h3[2], h3[3]}, o[d0], 0, 0, 0);
#undef TRR
    }
#undef TRRD
}
constexpr float THR2 = 5.f;
__device__ __forceinline__ float max3f(float a, float b, float c) { return __builtin_fmaxf(__builtin_fmaxf(a, b), c); }
__device__ __forceinline__ void softmax_sub(f32x16& p, float& m_reg, float& l_reg, float& alpha, bool& resc, bf16x8& pa0, bf16x8& pa1) {
    float pa_ = max3f(p[0], p[1], p[2]), pb_ = max3f(p[3], p[4], p[5]);
    pa_ = max3f(pa_, p[6], p[7]); pb_ = max3f(pb_, p[8], p[9]); pa_ = max3f(pa_, p[10], p[11]); pb_ = max3f(pb_, p[12], p[13]); pa_ = max3f(pa_, p[14], p[15]);
    float pmax = __builtin_fmaxf(pa_, pb_);
    { auto rr = __builtin_amdgcn_permlane32_swap(__float_as_uint(pmax), __float_as_uint(pmax), false, false); pmax = __builtin_fmaxf(__uint_as_float(rr[0]), __uint_as_float(rr[1])); }
    resc = !__all(pmax - m_reg <= THR2);
    alpha = 1.f;
    if (resc) { const float mn = __builtin_fmaxf(m_reg, pmax); alpha = __builtin_amdgcn_exp2f(m_reg - mn); m_reg = mn; l_reg *= alpha; }
    const float mn2 = m_reg;
    float ps = 0.f;
#pragma unroll
    for (int r = 0; r < 16; ++r) { p[r] = __builtin_amdgcn_exp2f(p[r] - mn2); ps += p[r]; }
    { auto rr = __builtin_amdgcn_permlane32_swap(__float_as_uint(ps), __float_as_uint(ps), false, false); ps = __uint_as_float(rr[0]) + __uint_as_float(rr[1]); }
    l_reg += ps;
    ATT_PK4(p, 0, pa0); ATT_PK4(p, 8, pa1);
}
__device__ __forceinline__ void softmax64(f32x16& p0, f32x16& p1, float& m_reg, float& l_reg, float& alpha, bool& resc, bf16x8& pa0, bf16x8& pa1, bf16x8& pa2, bf16x8& pa3) {
    float xa = max3f(p0[0], p0[1], p0[2]), xb = max3f(p0[3], p0[4], p0[5]), xc = max3f(p1[0], p1[1], p1[2]), xd = max3f(p1[3], p1[4], p1[5]);
    xa = max3f(xa, p0[6], p0[7]); xb = max3f(xb, p0[8], p0[9]); xc = max3f(xc, p1[6], p1[7]); xd = max3f(xd, p1[8], p1[9]);
    xa = max3f(xa, p0[10], p0[11]); xb = max3f(xb, p0[12], p0[13]); xc = max3f(xc, p1[10], p1[11]); xd = max3f(xd, p1[12], p1[13]);
    xa = max3f(xa, p0[14], p0[15]); xc = max3f(xc, p1[14], p1[15]);
    float pmax = __builtin_fmaxf(__builtin_fmaxf(xa, xb), __builtin_fmaxf(xc, xd));
    { auto rr = __builtin_amdgcn_permlane32_swap(__float_as_uint(pmax), __float_as_uint(pmax), false, false); pmax = __builtin_fmaxf(__uint_as_float(rr[0]), __uint_as_float(rr[1])); }
    resc = !__all(pmax - m_reg <= THR2);
    alpha = 1.f;
    if (resc) { const float mn = __builtin_fmaxf(m_reg, pmax); alpha = __builtin_amdgcn_exp2f(m_reg - mn); m_reg = mn; l_reg *= alpha; }
    const float mn2 = m_reg;
    float s0 = 0.f, s1 = 0.f, s2 = 0.f, s3 = 0.f;
#pragma unroll
    for (int r = 0; r < 16; r += 2) { p0[r] = __builtin_amdgcn_exp2f(p0[r] - mn2); s0 += p0[r]; p0[r + 1] = __builtin_amdgcn_exp2f(p0[r + 1] - mn2); s1 += p0[r + 1]; }
#pragma unroll
    for (int r = 0; r < 16; r += 2) { p1[r] = __builtin_amdgcn_exp2f(p1[r] - mn2); s2 += p1[r]; p1[r + 1] = __builtin_amdgcn_exp2f(p1[r + 1] - mn2); s3 += p1[r + 1]; }
    float ps = (s0 + s1) + (s2 + s3);
    { auto rr = __builtin_amdgcn_permlane32_swap(__float_as_uint(ps), __float_as_uint(ps), false, false); ps = __uint_as_float(rr[0]) + __uint_as_float(rr[1]); }
    l_reg += ps;
    ATT_PK4(p0, 0, pa0); ATT_PK4(p0, 8, pa1); ATT_PK4(p1, 0, pa2); ATT_PK4(p1, 8, pa3);
}
__device__ __forceinline__ void softmax64_off(f32x16& p0, f32x16& p1, float c0, float& m_reg, float& l_reg, float& alpha, bool& resc, bf16x8& pa0, bf16x8& pa1, bf16x8& pa2, bf16x8& pa3) {
    float xa = max3f(p0[0], p0[1], p0[2]), xb = max3f(p0[3], p0[4], p0[5]), xc = max3f(p1[0], p1[1], p1[2]), xd = max3f(p1[3], p1[4], p1[5]);
    xa = max3f(xa, p0[6], p0[7]); xb = max3f(xb, p0[8], p0[9]); xc = max3f(xc, p1[6], p1[7]); xd = max3f(xd, p1[8], p1[9]);
    xa = max3f(xa, p0[10], p0[11]); xb = max3f(xb, p0[12], p0[13]); xc = max3f(xc, p1[10], p1[11]); xd = max3f(xd, p1[12], p1[13]);
    xa = max3f(xa, p0[14], p0[15]); xc = max3f(xc, p1[14], p1[15]);
    float pmax = __builtin_fmaxf(__builtin_fmaxf(xa, xb), __builtin_fmaxf(xc, xd));
    { auto rr = __builtin_amdgcn_permlane32_swap(__float_as_uint(pmax), __float_as_uint(pmax), false, false); pmax = __builtin_fmaxf(__uint_as_float(rr[0]), __uint_as_float(rr[1])); }
    resc = !__all((pmax + c0) - m_reg <= THR2);
    alpha = 1.f;
    if (resc) { const float mn = __builtin_fmaxf(m_reg, pmax + c0); alpha = __builtin_amdgcn_exp2f(m_reg - mn); m_reg = mn; l_reg *= alpha;
        const float sh = mn - c0;
#pragma unroll
        for (int r = 0; r < 16; ++r) { p0[r] -= sh; p1[r] -= sh; } }
    float s0 = 0.f, s1 = 0.f, s2 = 0.f, s3 = 0.f;
#pragma unroll
    for (int r = 0; r < 16; r += 2) { p0[r] = __builtin_amdgcn_exp2f(p0[r]); s0 += p0[r]; p0[r + 1] = __builtin_amdgcn_exp2f(p0[r + 1]); s1 += p0[r + 1]; }
#pragma unroll
    for (int r = 0; r < 16; r += 2) { p1[r] = __builtin_amdgcn_exp2f(p1[r]); s2 += p1[r]; p1[r + 1] = __builtin_amdgcn_exp2f(p1[r + 1]); s3 += p1[r + 1]; }
    float ps = (s0 + s1) + (s2 + s3);
    { auto rr = __builtin_amdgcn_permlane32_swap(__float_as_uint(ps), __float_as_uint(ps), false, false); ps = __uint_as_float(rr[0]) + __uint_as_float(rr[1]); }
    l_reg += ps;
    ATT_PK4(p0, 0, pa0); ATT_PK4(p0, 8, pa1); ATT_PK4(p1, 0, pa2); ATT_PK4(p1, 8, pa3);
}
template <int NB32> struct VFrag { s16x4 l0[NB32], h0[NB32], l1[NB32], h1[NB32]; };
template <int NB32, int VOFF> __device__ __forceinline__ void v_issue(VFrag<NB32>& f, int vb) {
#define TRRD(dst, off) asm volatile("ds_read_b64_tr_b16 %0, %1 offset:%2" : "=&v"(dst) : "v"(vb), "i"(off) : "memory")
    constexpr int KS = NB32 * 1024, HF = NB32 * 512;
#define VI_D0(D0) do { TRRD(f.l0[D0], VOFF + (D0) * 512); TRRD(f.h0[D0], VOFF + (D0) * 512 + HF); TRRD(f.l1[D0], VOFF + (D0) * 512 + KS); TRRD(f.h1[D0], VOFF + (D0) * 512 + KS + HF); } while (0)
    VI_D0(0); VI_D0(1); if constexpr (NB32 > 2) { VI_D0(2); VI_D0(3); }
#undef VI_D0
#undef TRRD
}
template <int NB32, bool SWAP = false> __device__ __forceinline__ void v_consume(f32x16* o, VFrag<NB32>& f, bf16x8 pa0, bf16x8 pa1) {
    asm volatile("s_waitcnt lgkmcnt(0)" : "+v"(f.l0[0]), "+v"(f.h0[0]), "+v"(f.l1[0]), "+v"(f.h1[0]), "+v"(f.l0[1]), "+v"(f.h0[1]), "+v"(f.l1[1]), "+v"(f.h1[1]) :: "memory");
    if constexpr (NB32 > 2) asm volatile("" : "+v"(f.l0[2]), "+v"(f.h0[2]), "+v"(f.l1[2]), "+v"(f.h1[2]), "+v"(f.l0[3]), "+v"(f.h0[3]), "+v"(f.l1[3]), "+v"(f.h1[3]));
    SBAR();
#pragma unroll
    for (int d0 = 0; d0 < NB32; ++d0) {
        const bf16x8 v0 = {f.l0[d0][0], f.l0[d0][1], f.l0[d0][2], f.l0[d0][3], f.h0[d0][0], f.h0[d0][1], f.h0[d0][2], f.h0[d0][3]};
        const bf16x8 v1 = {f.l1[d0][0], f.l1[d0][1], f.l1[d0][2], f.l1[d0][3], f.h1[d0][0], f.h1[d0][1], f.h1[d0][2], f.h1[d0][3]};
        if constexpr (SWAP) { o[d0] = __builtin_amdgcn_mfma_f32_32x32x16_bf16(v0, pa0, o[d0], 0, 0, 0); o[d0] = __builtin_amdgcn_mfma_f32_32x32x16_bf16(v1, pa1, o[d0], 0, 0, 0); }
        else { o[d0] = __builtin_amdgcn_mfma_f32_32x32x16_bf16(pa0, v0, o[d0], 0, 0, 0); o[d0] = __builtin_amdgcn_mfma_f32_32x32x16_bf16(pa1, v1, o[d0], 0, 0, 0); }
    }
}
}

#define MLA_VAR 0
#define NSA_VAR 0
namespace mla {
using namespace att;
constexpr int KP = 400, KT = 64 * KP, VT = 64 * 128 * 2;
constexpr int L_K = 0, L_V = 2 * KT, L_KS = L_V + 2 * VT, L_WS = L_KS + SEQ * 4, L_G = L_WS + NWAVES * 256, L_END = L_G + 2 * 192 * 4;
static_assert(L_END <= RING_BYTES, "MLA attention LDS");


__device__ __forceinline__ void attn_unit(Frame& F, int j, int b, int h, int qb, int dry, bool prestaged, int h_next) {
    int tid_ = F.tid; asm volatile("" : "+v"(tid_));
    const int tid = tid_, lane = tid & 63, wid = __builtin_amdgcn_readfirstlane(tid >> 6), r32 = lane & 31, hi = lane >> 5;
    const int hl = h & 7;
    const size_t rowbase = (size_t)b * SEQ; const int q0 = qb * 256;
    const bf16_t* kvh = h < 8 ? F.kvh() : F.kvh2(); const bf16_t* kpes = F.kpes(); bf16_t* pbuf = F.p1();
    const float* ssq1 = F.ssq1();
    LAS unsigned char* lds = F.lds + RING_OFF;
    LAS float* wsf = (LAS float*)(lds + L_WS) + wid * 64;
    const int NT = 4 * qb + 4;
    const int qlo = q0 + wid * 32, qpos = qlo + r32;
    const unsigned char* kpes_b = (const unsigned char*)(kpes + rowbase * 64);
    const unsigned char* kvh_b = (const unsigned char*)(kvh + rowbase * 2048 + hl * 256);
    int koff[4]; unsigned kpe_mask = 0u;
#pragma unroll
    for (int i = 0; i < 4; ++i) { const int x = (wid + 8 * i) * 64 + lane; const int row = x / 25; int ch = x - row * 25; if (ch == 24) ch = 23;
        if (ch < 8) { kpe_mask |= 1u << i; koff[i] = row * 128 + ch * 16; } else koff[i] = row * 4096 + (ch - 8) * 16; }
    int voff[2];
#pragma unroll
    for (int i = 0; i < 2; ++i) { const int x = (wid + 8 * i) * 64 + lane; const int sub = x >> 5, within = x & 31; const int kk = (sub >> 2) * 8 + (within >> 2);
        const int k = (kk & ~0xC) | ((kk & 4) << 1) | ((kk & 8) >> 1); voff[i] = k * 4096 + 256 + ((sub & 3) * 32 + (within & 3) * 8) * 2; }
#define GLDS(src, dst) __builtin_amdgcn_global_load_lds((const unsigned*)(src), (LAS unsigned*)(dst), 16, 0, 0)
#define STAGE_DMA(t, buf) do { const size_t ko = (size_t)(t) * 64; \
        _Pragma("unroll") for (int i = 0; i < 4; ++i) if (wid + 8 * i < 25) { \
            const unsigned char* sp_ = ((kpe_mask >> i) & 1u) ? kpes_b + ko * 128 + koff[i] : kvh_b + ko * 4096 + koff[i]; \
            GLDS(sp_, lds + L_K + (buf) * KT + (wid + 8 * i) * 1024); } \
        _Pragma("unroll") for (int i = 0; i < 2; ++i) GLDS(kvh_b + ko * 4096 + voff[i], lds + L_V + (buf) * VT + (wid + 8 * i) * 1024); } while (0)
    bf16x8 qr[12];
    {
        const size_t qrow = rowbase + qpos;
        constexpr int WP = 208, WCH = 192 * WP;
        const unsigned char* wsrc = (const unsigned char*)(mla_w(F.ws, j).wuq + (size_t)h * 192 * 384);
        int wrow[5], wch[5];
#pragma unroll
        for (int i = 0; i < 5; ++i) { const int x = (wid + 8 * i) * 64 + lane; wrow[i] = x / 13; wch[i] = x - wrow[i] * 13; if (wch[i] == 12) wch[i] = 11; }
#define STAGE_W(src, c, bi) do { _Pragma("unroll") for (int i = 0; i < 5; ++i) if (wid + 8 * i < 39) \
            GLDS((src) + (size_t)wrow[i] * 768 + (c) * 192 + wch[i] * 16, lds + (bi) * WCH + (wid + 8 * i) * 1024); } while (0)
        if (!prestaged) { STAGE_W(wsrc, 0, 0); STAGE_W(wsrc, 1, 1); }
        const bf16_t* cqp = pbuf + qrow * M_INP + hi * 8;
        u32x4 cq[24]; float sl[12];
#pragma unroll
        for (int ks = 0; ks < 24; ++ks) cq[ks] = *(const u32x4*)(cqp + ks * 16);
#pragma unroll
        for (int s = 0; s < 12; ++s) sl[s] = ssq1[(size_t)s * T + qrow];
        f32x16 qa[6] = {};
        const LAS unsigned char* wbase = lds + r32 * WP + hi * 16;
#define QMMA(c) do { _Pragma("unroll") for (int i = 0; i < 6; ++i) { _Pragma("unroll") for (int blk = 0; blk < 6; ++blk) { \
            const bf16x8 wa = *(const LAS bf16x8*)(wbase + ((c) & 1) * WCH + blk * 32 * WP + i * 32); \
            qa[blk] = __builtin_amdgcn_mfma_f32_32x32x16_bf16(wa, __builtin_bit_cast(bf16x8, cq[6 * (c) + i]), qa[blk], 0, 0, 0); } } } while (0)
#define BAR_RAW() do { asm volatile("s_waitcnt lgkmcnt(0)" ::: "memory"); __builtin_amdgcn_s_barrier(); asm volatile("" ::: "memory"); } while (0)
        __syncthreads();
        QMMA(0);
        BAR_RAW();
        STAGE_W(wsrc, 2, 0);
        QMMA(1);
        BAR_RAW();
        STAGE_W(wsrc, 3, 1);
        if (wid < 7) asm volatile("s_waitcnt vmcnt(5)" ::: "memory"); else asm volatile("s_waitcnt vmcnt(4)" ::: "memory");
        BAR_RAW();
        QMMA(2);
        asm volatile("s_waitcnt vmcnt(0)" ::: "memory");
        BAR_RAW();
        QMMA(3);
#undef QMMA
        __syncthreads();
        STAGE_DMA(0, 0);
        const LAS float* gql = (const LAS float*)(lds + L_G); const LAS float* gkl = gql + 192;
        float ss = 0.f, sscq = 0.f;
#pragma unroll
        for (int blk = 0; blk < 6; ++blk)
#pragma unroll
            for (int r = 0; r < 16; ++r) ss += qa[blk][r] * qa[blk][r];
        ss = sum_xor32(ss);
#pragma unroll
        for (int s = 0; s < 12; ++s) sscq += sl[s];
        const float a = rsqrtf(sscq * (1.f / 384.f) + EPS);
        const float sc = a * rsqrtf(a * a * ss * (1.f / 192.f) + EPS) * M_SCL2;
        const float* cp = F.cosM() + qrow * 32 + 4 * hi; const float* sp = F.sinM() + qrow * 32 + 4 * hi;
#pragma unroll
        for (int g4 = 0; g4 < 4; ++g4) {
            const f32x4 cs = *(const f32x4*)(cp + 8 * g4), sn = *(const f32x4*)(sp + 8 * g4);
            const f32x4 g1 = *(const LAS f32x4*)(gql + 8 * g4 + 4 * hi), g2 = *(const LAS f32x4*)(gql + 32 + 8 * g4 + 4 * hi);
#pragma unroll
            for (int e = 0; e < 4; ++e) { const int r = 4 * g4 + e; const float u = qa[0][r] * sc * g1[e], v = qa[1][r] * sc * g2[e];
                qa[0][r] = u * cs[e] - v * sn[e]; qa[1][r] = v * cs[e] + u * sn[e]; } }
#pragma unroll
        for (int blk = 2; blk < 6; ++blk)
#pragma unroll
            for (int g4 = 0; g4 < 4; ++g4) { const f32x4 gg = *(const LAS f32x4*)(gkl + 32 * blk + 8 * g4 + 4 * hi);
#pragma unroll
                for (int e = 0; e < 4; ++e) qa[blk][4 * g4 + e] *= sc * gg[e]; }
#pragma unroll
        for (int d0 = 0; d0 < 12; ++d0) { if (d0 & 1) ATT_PK4(qa[d0 >> 1], 8, qr[d0]); else ATT_PK4(qa[d0 >> 1], 0, qr[d0]); }
    }
    __syncthreads();
    float m_reg = -1e30f, l_reg = 0.f; f32x16 o[4] = {};
    const LAS unsigned char* kbase = lds + L_K + r32 * KP + hi * 16;
    const LAS unsigned char* ksb = lds + L_KS + hi * 16;
    const int vb0 = (int)(uintptr_t)(lds + L_V) + v_rd_base(lane);
#define SUBTILE(BUF, t, SUB) do { const int kb0_ = (t) * 64 + 32 * (SUB); \
        if (kb0_ <= qlo + 31 && (MLA_VAR != 8 || wid < 4) && (MLA_VAR != 9 || (wid & 1) == 0)) { f32x16 p = {}; \
            if (MLA_VAR != 4) { bf16x8 kf_[12]; \
                _Pragma("unroll") for (int d0 = 0; d0 < 12; ++d0) kf_[d0] = *(const LAS bf16x8*)(kbase + (BUF) * KT + (SUB) * 32 * KP + d0 * 32); \
                SBAR(); \
                _Pragma("unroll") for (int d0 = 0; d0 < 12; ++d0) p = __builtin_amdgcn_mfma_f32_32x32x16_bf16(kf_[d0], qr[d0], p, 0, 0, 0); } \
            const LAS unsigned char* ksp_ = ksb + kb0_ * 4; \
            _Pragma("unroll") for (int g = 0; g < 4; ++g) { const f32x4 s0 = *(const LAS f32x4*)(ksp_ + g * 32); \
                _Pragma("unroll") for (int e = 0; e < 4; ++e) p[4 * g + e] *= s0[e]; } \
            if (kb0_ + 31 > qlo) { const float NEG = -__builtin_inff(); \
                _Pragma("unroll") for (int r = 0; r < 16; ++r) { if (kb0_ + crow(r, hi) > qpos) p[r] = NEG; } } \
            VFrag<4> vf; if (MLA_VAR != 3) v_issue<4, (BUF) * VT + 2 * (SUB) * 4096>(vf, vb0); \
            float alpha = 1.f; bool resc = false; bf16x8 pa0, pa1; \
            if (MLA_VAR != 2) softmax_sub(p, m_reg, l_reg, alpha, resc, pa0, pa1); else { pa0 = pack8((f32x4){p[0], p[1], p[2], p[3]}, (f32x4){p[4], p[5], p[6], p[7]}); pa1 = pack8((f32x4){p[8], p[9], p[10], p[11]}, (f32x4){p[12], p[13], p[14], p[15]}); } \
            if (resc) { _Pragma("unroll") for (int r = 0; r < 16; ++r) { o[0][r] *= alpha; o[1][r] *= alpha; o[2][r] *= alpha; o[3][r] *= alpha; } }     \
            v_consume<4, true>(o, vf, pa0, pa1); \
        } } while (0)
    for (int t = 0; t < ((MLA_VAR >= 10 && MLA_VAR <= 12) ? 0 : NT); t += 2) {
        if (wid < 4) STAGE_DMA(t + 1, 1);
        SUBTILE(0, t, 0);
        if (wid >= 4) STAGE_DMA(t + 1, 1);
        SUBTILE(0, t, 1);
        __syncthreads();
        if (t + 2 < NT && wid < 4) STAGE_DMA(t + 2, 0);
        SUBTILE(1, t + 1, 0);
        if (t + 2 < NT && wid >= 4) STAGE_DMA(t + 2, 0);
        SUBTILE(1, t + 1, 1);
        __syncthreads();
    }
    if (h_next >= 0) {
        constexpr int WP = 208, WCH = 192 * WP;
        const unsigned char* wsrc = (const unsigned char*)(mla_w(F.ws, j).wuq + (size_t)h_next * 192 * 384);
        int wrow[5], wch[5];
#pragma unroll
        for (int i = 0; i < 5; ++i) { const int x = (wid + 8 * i) * 64 + lane; wrow[i] = x / 13; wch[i] = x - wrow[i] * 13; if (wch[i] == 12) wch[i] = 11; }
        STAGE_W(wsrc, 0, 0); STAGE_W(wsrc, 1, 1);
    }
#undef STAGE_W
#undef BAR_RAW
    {
        const float rl = 1.f / l_reg;
        bf16_t* zrow = pbuf + (rowbase + qpos) * M_INP + M_Z + h * 128 + 8 * hi;
        u32x4 zz[4][2];
#pragma unroll
        for (int d0 = 0; d0 < 4; ++d0)
#pragma unroll
            for (int gp = 0; gp < 2; ++gp) zz[d0][gp] = *(const u32x4*)(zrow + d0 * 32 + gp * 16);
#pragma unroll
        for (int d0 = 0; d0 < 4; ++d0)
#pragma unroll
            for (int gp = 0; gp < 2; ++gp) {
                float ov[8], zf[8];
#pragma unroll
                for (int e = 0; e < 4; ++e) { auto rr = __builtin_amdgcn_permlane32_swap(__float_as_uint(o[d0][8 * gp + e]), __float_as_uint(o[d0][8 * gp + 4 + e]), false, false);
                    ov[e] = __uint_as_float(rr[0]); ov[4 + e] = __uint_as_float(rr[1]); }
                unpack8(zz[d0][gp], zf);
#pragma unroll
                for (int e = 0; e < 8; ++e) ov[e] = ov[e] * rl * zf[e] / (1.f + __expf(-zf[e]));
                if (!dry) *(bf16x8*)(zrow + d0 * 32 + gp * 16) = pack8((f32x4){ov[0], ov[1], ov[2], ov[3]}, (f32x4){ov[4], ov[5], ov[6], ov[7]});
            }
    }
#undef STAGE_DMA
#undef GLDS
#undef SUBTILE
}

__device__ __forceinline__ void phase_attn(Frame& F, int j, int dry) {
    const int bx = blockIdx.x, vcu = (bx & 7) * (GRID / 8) + (bx >> 3);
    { LAS float* gl = (LAS float*)(F.lds + RING_OFF + L_G); const float* gq = F.f(I_MGQ) + j * 192; const float* gk = F.f(I_MGK) + j * 192;
      if (F.tid < 192) { const float g = gq[F.tid]; gl[F.tid] = g; gl[192 + F.tid] = g * gk[F.tid]; } }
    if (F.wave >= 4) __builtin_amdgcn_s_setprio(1);
    for (int it = 0; it < 2; ++it) {
        const int item = it * GRID + vcu, bh = item >> 3, s = item & 7, b = bh >> 4, h = bh & 15;
        {
            const float* ssq1 = F.ssq1(); const float* ssqkn = F.ssqkn() + (size_t)h * 4 * T; LAS float* ksl = (LAS float*)(F.lds + RING_OFF + L_KS);
            const int nk = 256 * (16 - s);
            for (int k0 = 0; k0 < nk; k0 += 4 * NWAVES * 64) { float ssv[4];
#pragma unroll
                for (int u = 0; u < 4; ++u) { const int k = k0 + u * NWAVES * 64 + F.tid; const size_t kr = (size_t)b * SEQ + (k < nk ? k : 0);
                    ssv[u] = (ssq1[(size_t)20 * T + kr] + ssq1[(size_t)21 * T + kr]) + (ssqkn[kr] + ssqkn[T + kr]) + (ssqkn[2 * (size_t)T + kr] + ssqkn[3 * (size_t)T + kr]); }
#pragma unroll
                for (int u = 0; u < 4; ++u) { const int k = k0 + u * NWAVES * 64 + F.tid; if (k < nk) ksl[k] = rsqrtf(ssv[u] * (1.f / 192.f) + EPS); } }
            __syncthreads();
        }
        const int h2 = (((it + 1) * GRID + vcu) >> 3) & 15;
        attn_unit(F, j, b, h, 15 - s, dry, it == 1, h);
        attn_unit(F, j, b, h, s, dry, true, it == 0 ? h2 : -1);
    }
    __builtin_amdgcn_s_setprio(0);
}
}
namespace nsap {
using namespace att;
__device__ __forceinline__ void post_rows(Frame& F, int j, int dry) {
    int tid_ = F.tid; asm volatile("" : "+v"(tid_));
    const int tid = tid_, lane = tid & 63, wid = __builtin_amdgcn_readfirstlane(tid >> 6);
    bf16_t* pbuf = F.p1(); const float* gq = F.f(I_NGQ) + j * 96; const float* gk = F.f(I_NGK) + j * 288;
    const float* cosN = F.cosN(); const float* sinN = F.sinN();
    const int part = lane & 3;
    constexpr int NU = T * 8;
    for (int u0 = (blockIdx.x * NWAVES + wid) * 32 + (lane >> 2); u0 < NU; u0 += GRID * NWAVES * 32) {
        bf16_t* p[2]; const float* g[2]; float post[2]; int row[2]; float x[2][24];
#pragma unroll
        for (int k = 0; k < 2; ++k) { const int u = u0 + 16 * k; row[k] = u >> 3; const int un = u & 7;
            if (un < 4) { p[k] = pbuf + (size_t)row[k] * N_INP + N_KS + un * 96 + part * 24; g[k] = gk + 96 + part * 24; post[k] = 1.f; }
            else { p[k] = pbuf + (size_t)row[k] * N_INP + N_KW + (un - 4) * 96 + part * 24; g[k] = gk + 192 + part * 24; post[k] = 1.f; }
#pragma unroll
            for (int i = 0; i < 3; ++i) unpack8(*(const u32x4*)(p[k] + 8 * i), x[k] + 8 * i); }
#pragma unroll
        for (int k = 0; k < 2; ++k) { float ss = 0.f;
#pragma unroll
            for (int i = 0; i < 24; ++i) ss += x[k][i] * x[k][i];
            ss += get_xor1(ss); ss += get_xor2(ss);
            const float r = rsqrtf(ss * (1.f / 96.f) + EPS) * post[k];
#pragma unroll
            for (int i = 0; i < 24; ++i) x[k][i] *= r * g[k][i];
            if (part == 0) {
#pragma unroll
                for (int f = 0; f < 12; ++f) { const float c = cosN[row[k] * 12 + f], s = sinN[row[k] * 12 + f]; const float a = x[k][f], b2 = x[k][12 + f]; x[k][f] = a * c - b2 * s; x[k][12 + f] = b2 * c + a * s; } }
#pragma unroll
            for (int i = 0; i < 3; ++i) if (!dry) *(bf16x8*)(p[k] + 8 * i) = pack8((f32x4){x[k][8 * i], x[k][8 * i + 1], x[k][8 * i + 2], x[k][8 * i + 3]}, (f32x4){x[k][8 * i + 4], x[k][8 * i + 5], x[k][8 * i + 6], x[k][8 * i + 7]}); }
    }
}

constexpr int L_PART = 0, L_HID = 8 * 32 * 96 * 4, L_OUT = L_HID + 32 * 96 * 2, L_CEND = L_OUT + 32 * 96 * 4;
static_assert(L_CEND <= RING_BYTES, "compress LDS");
template <int DD>
__device__ __forceinline__ void compress_unit(Frame& F, int j, int b, int g, int nb) {
    int tid_ = F.tid; asm volatile("" : "+v"(tid_));
    const int tid = tid_, lane = tid & 63, wid = __builtin_amdgcn_readfirstlane(tid >> 6), r32 = lane & 31, hi = lane >> 5;
    constexpr int NC = DD / 32, KPT = DD / 16, KTOT = 32 * DD, COFF = DD == 96 ? N_KC : N_VC;
    const NsaW W = nsa_w(F.ws, j);
    const bf16_t* w1t = DD == 96 ? W.w1k : W.w1v; const bf16_t* w2t = DD == 96 ? W.w2k : W.w2v;
    const float* pe = (DD == 96 ? F.f(I_NPEK) + j * 32 * 96 : F.f(I_NPEV) + j * 32 * 64) + hi * 8;
    const bf16_t* pbuf = F.p1(); LAS unsigned char* lds = F.lds + RING_OFF;
    const size_t rowbase = (size_t)b * SEQ;
    int n = 32 * nb + r32; if (n > NCMP - 1) n = NCMP - 1;
    f32x16 acc[NC] = {};
#pragma unroll 2
    for (int li = 0; li < 4; ++li) {
        const int l = 4 * wid + li;
        const bf16_t* ap = pbuf + (rowbase + 16 * n + l) * N_INP + COFF + g * DD + hi * 8;
        const bf16_t* bp = w1t + (size_t)r32 * KTOT + l * DD + hi * 8;
#pragma unroll
        for (int kk = 0; kk < KPT; ++kk) {
            float af[8]; unpack8(*(const u32x4*)(ap + kk * 16), af);
            const f32x4 pe0 = *(const f32x4*)(pe + l * DD + kk * 16), pe1 = *(const f32x4*)(pe + l * DD + kk * 16 + 4);
            const bf16x8 a = pack8((f32x4){af[0] + pe0[0], af[1] + pe0[1], af[2] + pe0[2], af[3] + pe0[3]}, (f32x4){af[4] + pe1[0], af[5] + pe1[1], af[6] + pe1[2], af[7] + pe1[3]});
#pragma unroll
            for (int cb = 0; cb < NC; ++cb) { const bf16x8 bb = *(const bf16x8*)(bp + (size_t)cb * 32 * KTOT + kk * 16);
                acc[cb] = __builtin_amdgcn_mfma_f32_32x32x16_bf16(a, bb, acc[cb], 0, 0, 0); }
        }
    }
    LAS float* part = (LAS float*)(lds + L_PART) + wid * 32 * DD;
#pragma unroll
    for (int cb = 0; cb < NC; ++cb)
#pragma unroll
        for (int r = 0; r < 16; ++r) part[crow(r, hi) * DD + cb * 32 + r32] = acc[cb][r];
    __syncthreads();
    LAS bf16_t* hid = (LAS bf16_t*)(lds + L_HID);
    for (int e = tid; e < 32 * DD; e += NWAVES * 64) { float s = 0.f;
#pragma unroll
        for (int w = 0; w < 8; ++w) s += ((LAS float*)(lds + L_PART))[w * 32 * DD + e];
        hid[e] = f2bf(s / (1.f + __expf(-s))); }
    __syncthreads();
    LAS float* outl = (LAS float*)(lds + L_OUT);
    if (wid < NC) {
        f32x16 a2 = {};
#pragma unroll
        for (int kk = 0; kk < KPT; ++kk) {
            const bf16x8 a = *(const LAS bf16x8*)(hid + r32 * DD + kk * 16 + hi * 8);
            const bf16x8 bb = *(const bf16x8*)(w2t + (size_t)(wid * 32 + r32) * DD + kk * 16 + hi * 8);
            a2 = __builtin_amdgcn_mfma_f32_32x32x16_bf16(a, bb, a2, 0, 0, 0);
        }
#pragma unroll
        for (int r = 0; r < 16; ++r) outl[crow(r, hi) * DD + wid * 32 + r32] = a2[r];
    }
    __syncthreads();
    if constexpr (DD == 96) {
        if (tid < 128) {
            const int row = tid >> 2, prt = tid & 3, nn = 32 * nb + row;
            const float* g0 = F.f(I_NGK) + j * 288 + prt * 24;
            float x[24]; float ss = 0.f;
#pragma unroll
            for (int i = 0; i < 24; ++i) { x[i] = outl[row * 96 + prt * 24 + i]; ss += x[i] * x[i]; }
            ss += get_xor1(ss); ss += get_xor2(ss);
            const float r = rsqrtf(ss * (1.f / 96.f) + EPS);
#pragma unroll
            for (int i = 0; i < 24; ++i) x[i] *= r * g0[i];
            if (prt == 0) { const size_t tp = rowbase + 16 * nn + 31; const float* cp = F.cosN() + tp * 12; const float* sp = F.sinN() + tp * 12;
                if (nn < NCMP) {
#pragma unroll
                    for (int f = 0; f < 12; ++f) { const float c = cp[f], s = sp[f]; const float a = x[f], b2 = x[12 + f]; x[f] = a * c - b2 * s; x[12 + f] = b2 * c + a * s; } } }
            if (nn >= NCMP) {
#pragma unroll
                for (int i = 0; i < 24; ++i) x[i] = 0.f; }
            bf16_t* dst = F.kcmp() + (((size_t)b * 4 + g) * 256 + nn) * 96 + prt * 24;
#pragma unroll
            for (int i = 0; i < 3; ++i) *(bf16x8*)(dst + 8 * i) = pack8((f32x4){x[8 * i], x[8 * i + 1], x[8 * i + 2], x[8 * i + 3]}, (f32x4){x[8 * i + 4], x[8 * i + 5], x[8 * i + 6], x[8 * i + 7]});
        }
    } else {
        if (tid < 256) {
            const int row = tid >> 3, ch = tid & 7, nn = 32 * nb + row; float x[8];
#pragma unroll
            for (int i = 0; i < 8; ++i) x[i] = nn < NCMP ? outl[row * 64 + ch * 8 + i] : 0.f;
            *(bf16x8*)(F.vcmp() + (((size_t)b * 4 + g) * 256 + nn) * 64 + ch * 8) = pack8((f32x4){x[0], x[1], x[2], x[3]}, (f32x4){x[4], x[5], x[6], x[7]});
        }
    }
    __syncthreads();
}

__device__ __forceinline__ void phase_post(Frame& F, int j, int dry) {
    const int u = blockIdx.x;
    const int kind = u >> 7, r = u & 127, b = r >> 5, g = (r >> 3) & 3, nb = r & 7;
    if (kind == 0) compress_unit<96>(F, j, b, g, nb); else compress_unit<64>(F, j, b, g, nb);
    post_rows(F, j, dry);
}
}
namespace nsa {
using namespace att;
constexpr int KP = 208, KT = 64 * KP, VT = 16384;
constexpr int L_K = 0, L_V = 2 * KT, L_IMP = L_V + 2 * VT, L_SELM = L_IMP + 64 * 64 * 4, L_SCJ = L_SELM + 512, L_WS = L_SCJ + NWAVES * 256, L_GATE = L_WS + NWAVES * 256,
              L_UNI = L_GATE + NWAVES * 512, L_END = L_UNI + 16;
static_assert(L_END <= RING_BYTES, "NSA attention LDS");

__device__ __forceinline__ void attn_unit(Frame& F, int jl, int b, int g, int c, int dry) {
    int tid_ = F.tid; asm volatile("" : "+v"(tid_));
    const int tid = tid_, lane = tid & 63, wid = __builtin_amdgcn_readfirstlane(tid >> 6), r32 = lane & 31, hi = lane >> 5;
    LAS unsigned char* lds = F.lds + RING_OFF;
    bf16_t* pbuf = F.p1();
    const size_t rowbase = (size_t)b * SEQ;
    const int tpos = 64 * c + 8 * wid + (r32 >> 2);
    int krow[2], kch[2];
#pragma unroll
    for (int i = 0; i < 2; ++i) { const int x = (wid + 8 * i) * 64 + lane; krow[i] = x / 13; kch[i] = x - krow[i] * 13; if (kch[i] == 12) kch[i] = 11; }
    int vk2, vc2, vk4, vc4;
    { const int sub = wid * 2 + (lane >> 5), within = lane & 31; const int kk = (sub >> 1) * 8 + (within >> 2); vk2 = (kk & ~0xC) | ((kk & 4) << 1) | ((kk & 8) >> 1); vc2 = (sub & 1) * 32 + (within & 3) * 8; }
    { const int within = lane & 31; const int kk = wid * 8 + (within >> 2); vk4 = (kk & ~0xC) | ((kk & 4) << 1) | ((kk & 8) >> 1); vc4 = (lane >> 5) * 32 + (within & 3) * 8; }
#define GLDS(src, dst) __builtin_amdgcn_global_load_lds((const unsigned*)(src), (LAS unsigned*)(dst), 16, 0, 0)
#define STAGE_K(buf, kptr, kstride, row0) do { _Pragma("unroll") for (int i = 0; i < 2; ++i) if (wid + 8 * i < 13) \
        GLDS((const unsigned char*)(kptr) + (size_t)((row0) + krow[i]) * (kstride) + kch[i] * 16, lds + L_K + (buf) * KT + (wid + 8 * i) * 1024); } while (0)
    bf16x8 qr[6]; float gate[3];
#define Q_AND_GATES() do { \
    { const size_t qrow_ = rowbase + tpos; const bf16_t* qp = pbuf + qrow_ * N_INP + N_Q + (4 * g + (r32 & 3)) * 96 + hi * 8; \
      const float* gq_ = F.f(I_NGQ) + jl * 96 + hi * 8; const float* cp_ = F.cosN() + qrow_ * 12; const float* sp_ = F.sinN() + qrow_ * 12; \
      u32x4 raw_[6]; f32x4 gg_[6][2]; f32x4 cs_[3], sn_[3]; \
      for (int d0 = 0; d0 < 6; ++d0) { raw_[d0] = *(const u32x4*)(qp + d0 * 16); gg_[d0][0] = *(const f32x4*)(gq_ + d0 * 16); gg_[d0][1] = *(const f32x4*)(gq_ + d0 * 16 + 4); } \
      for (int i = 0; i < 3; ++i) { cs_[i] = *(const f32x4*)(cp_ + 4 * i); sn_[i] = *(const f32x4*)(sp_ + 4 * i); } \
      float x_[6][8]; float ss_ = 0.f; \
      for (int d0 = 0; d0 < 6; ++d0) { unpack8(raw_[d0], x_[d0]); for (int e = 0; e < 8; ++e) ss_ += x_[d0][e] * x_[d0][e]; } \
      ss_ = sum_xor32(ss_); \
      const float rn_ = rsqrtf(ss_ * (1.f / 96.f) + EPS) * N_SCL2; \
      for (int d0 = 0; d0 < 6; ++d0) for (int e = 0; e < 8; ++e) x_[d0][e] *= rn_ * gg_[d0][e >> 2][e & 3]; \
      float y0_[8], y1_[4]; \
      for (int e = 0; e < 8; ++e) y0_[e] = get_xor32(x_[0][e], hi);            \
      for (int e = 0; e < 4; ++e) y1_[e] = get_xor32(x_[1][4 + e], hi);        \
      if (hi == 0) { \
          for (int e = 0; e < 4; ++e) { const float a_ = x_[0][e], b_ = y0_[4 + e]; x_[0][e] = a_ * cs_[0][e] - b_ * sn_[0][e]; }                           \
          for (int e = 0; e < 4; ++e) { const float a_ = x_[0][4 + e], b_ = x_[1][e]; x_[0][4 + e] = a_ * cs_[1][e] - b_ * sn_[1][e]; x_[1][e] = b_ * cs_[1][e] + a_ * sn_[1][e]; }     \
          for (int e = 0; e < 4; ++e) { const float a_ = y0_[e], b_ = x_[1][4 + e]; x_[1][4 + e] = b_ * cs_[2][e] + a_ * sn_[2][e]; }                       \
      } else { \
          for (int e = 0; e < 4; ++e) { const float a_ = x_[0][e], b_ = y1_[e]; x_[0][e] = a_ * cs_[2][e] - b_ * sn_[2][e]; }                               \
          for (int e = 0; e < 4; ++e) { const float a_ = y0_[e], b_ = x_[0][4 + e]; x_[0][4 + e] = b_ * cs_[0][e] + a_ * sn_[0][e]; }                       \
      } \
      for (int d0 = 0; d0 < 6; ++d0) qr[d0] = pack8((f32x4){x_[d0][0], x_[d0][1], x_[d0][2], x_[d0][3]}, (f32x4){x_[d0][4], x_[d0][5], x_[d0][6], x_[d0][7]}); } \
    { const bf16_t* gp = pbuf + (rowbase + tpos) * N_INP + N_GL + (4 * g + (r32 & 3)) * 3; \
        for (int i = 0; i < 3; ++i) gate[i] = 1.f / (1.f + __expf(-bf2f(gp[i]))); } \
    } while (0)
    const LAS unsigned char* kbase = lds + L_K + r32 * KP + hi * 16;
    const int vb0 = (int)(uintptr_t)(lds + L_V) + v_rd_base(lane);
    float m_reg, l_reg; int lo_lim, hi_lim;
    f32x16 acc[2] = {};
#define TILE64(NB, BUF, kb0, O, WACT, SELOK) do { const int kb0_ = (kb0); \
        if ((WACT) && __any(hi_lim >= kb0_ && lo_lim <= kb0_ + 63)) { \
            const float c0_ = m_reg > -1e29f ? m_reg : 0.f; const float pi_ = (SELOK) ? -c0_ : -__builtin_inff(); f32x16 p0, p1; \
            _Pragma("unroll") for (int r = 0; r < 16; ++r) { p0[r] = pi_; p1[r] = pi_; } \
            { bf16x8 kf_[12]; \
              _Pragma("unroll") for (int d0 = 0; d0 < 6; ++d0) { kf_[2 * d0] = *(const LAS bf16x8*)(kbase + (BUF) * KT + d0 * 32); kf_[2 * d0 + 1] = *(const LAS bf16x8*)(kbase + (BUF) * KT + 32 * KP + d0 * 32); } \
              SBAR(); \
              _Pragma("unroll") for (int d0 = 0; d0 < 6; ++d0) { p0 = __builtin_amdgcn_mfma_f32_32x32x16_bf16(kf_[2 * d0], qr[d0], p0, 0, 0, 0); p1 = __builtin_amdgcn_mfma_f32_32x32x16_bf16(kf_[2 * d0 + 1], qr[d0], p1, 0, 0, 0); } } \
            if (__any(kb0_ + 63 > hi_lim || kb0_ < lo_lim)) { const float NEG = -__builtin_inff(); \
                _Pragma("unroll") for (int r = 0; r < 16; ++r) { const int kk_ = kb0_ + crow(r, hi); if (kk_ > hi_lim || kk_ < lo_lim) p0[r] = NEG; if (kk_ + 32 > hi_lim || kk_ + 32 < lo_lim) p1[r] = NEG; } } \
            VFrag<NB> va, vb; v_issue<NB, (BUF) * VT>(va, vb0); if (NB == 2) v_issue<NB, (BUF) * VT + 2 * NB * 1024>(vb, vb0); \
            float alpha; bool resc; bf16x8 pa0, pa1, pa2, pa3; \
            softmax64_off(p0, p1, c0_, m_reg, l_reg, alpha, resc, pa0, pa1, pa2, pa3); \
            if (resc) { _Pragma("unroll") for (int r = 0; r < 16; ++r) { _Pragma("unroll") for (int d_ = 0; d_ < NB; ++d_) O[d_][r] *= alpha; } }     \
            v_consume<NB, true>(O, va, pa0, pa1); \
            if (NB != 2) v_issue<NB, (BUF) * VT + 2 * NB * 1024>(vb, vb0); \
            v_consume<NB, true>(O, vb, pa2, pa3); \
        } } while (0)
    {
        const bf16_t* kc = F.kcmp() + ((size_t)b * 4 + g) * 256 * 96; const bf16_t* vc = F.vcmp() + ((size_t)b * 4 + g) * 256 * 64;
        f32x16 o[4] = {}; m_reg = -1e30f; l_reg = 0.f;
        hi_lim = (tpos - 31) >> 4; lo_lim = -(1 << 30);
        const int ntc = (NSA_VAR == 10 || NSA_VAR == 13) ? 0 : (4 * c + 3) / 64 + 1;
#define STAGE_C(t, buf) do { STAGE_K(buf, kc, 192, (t) * 64); \
        GLDS((const unsigned char*)vc + (size_t)((t) * 64 + vk4) * 128 + vc4 * 2, lds + L_V + (buf) * VT + (2 * wid) * 1024); \
        { const int n_ = (t) * 64 + vk4; const int j0_ = vc4; unsigned w_[4]; \
          _Pragma("unroll") for (int e = 0; e < 4; ++e) { const int ja = j0_ + 2 * e, jb = ja + 1; \
              w_[e] = ((n_ >= 4 * ja - 1 && n_ <= 4 * ja + 3) ? 0x3f80u : 0u) | ((n_ >= 4 * jb - 1 && n_ <= 4 * jb + 3) ? 0x3f800000u : 0u); } \
          *(LAS u32x4*)(lds + L_V + (buf) * VT + (2 * wid + 1) * 1024 + lane * 16) = (u32x4){w_[0], w_[1], w_[2], w_[3]}; } } while (0)
        if (ntc) STAGE_C(0, 0);
        Q_AND_GATES();
        __syncthreads();
        for (int t = 0; t < ntc; t += 2) {
            if (t + 1 < ntc) STAGE_C(t + 1, 1);
            TILE64(4, 0, t * 64, o, true, true);
            __syncthreads();
            if (t + 1 < ntc) {
                if (t + 2 < ntc) STAGE_C(t + 2, 0);
                TILE64(4, 1, (t + 1) * 64, o, true, true);
                __syncthreads();
            }
        }
#undef STAGE_C
        {
            const float rl = l_reg > 0.f ? 1.f / l_reg : 0.f, gr = gate[0] * rl;
            LAS float* imp = (LAS float*)(lds + L_IMP) + (8 * wid + (r32 >> 2)) * 64 + 4 * hi;
#pragma unroll
            for (int r = 0; r < 16; ++r) { acc[0][r] = o[0][r] * gr; acc[1][r] = o[1][r] * gr; }
#pragma unroll
            for (int d = 0; d < 2; ++d)
#pragma unroll
                for (int q4 = 0; q4 < 4; ++q4) { f32x4 iv;
#pragma unroll
                    for (int e = 0; e < 4; ++e) { float v = o[2 + d][4 * q4 + e] * rl; v += get_xor1(v); v += get_xor2(v); iv[e] = v; }
                    if ((r32 & 3) == 0) *(LAS f32x4*)(imp + d * 32 + 8 * q4) = iv; }
        }
    }
#define STAGE_SW(j, buf, koffc, voffc) do { STAGE_K(buf, pbuf + rowbase * N_INP + (koffc) + g * 96, N_INP * 2, (j) * 64); \
    GLDS((const unsigned char*)(pbuf + rowbase * N_INP + (voffc) + g * 64) + (size_t)((j) * 64 + vk2) * (N_INP * 2) + vc2 * 2, lds + L_V + (buf) * VT + wid * 1024); } while (0)
    STAGE_SW(0, 0, N_KS, N_VS);
    unsigned long long mysel = 0ull, wsel = 0ull;
    {
        LAS float* imp = (LAS float*)(lds + L_IMP); LAS float* scj = (LAS float*)(lds + L_SCJ) + wid * 64;
        LAS unsigned long long* selm = (LAS unsigned long long*)(lds + L_SELM);
        asm volatile("s_waitcnt lgkmcnt(0)" ::: "memory");
        if (!(NSA_VAR == 7 || NSA_VAR == 12 || NSA_VAR == 13)) {
            const int j = lane; const bool forced = (j == 0) || (j == c) || (j == c - 1);
            unsigned key[8], prefix[8];
#pragma unroll
            for (int tl = 0; tl < 8; ++tl) { const float v = imp[(8 * wid + tl) * 64 + j]; const float me = forced ? 1e4f : ((j <= c) ? v : -1.f);
                const unsigned ub = __float_as_uint(me); key[tl] = (ub & 0x80000000u) ? ~ub : (ub | 0x80000000u); prefix[tl] = 0u; }
            for (int bit = 31; bit >= 0; --bit) {
#pragma unroll
                for (int tl = 0; tl < 8; ++tl) { const unsigned cand = prefix[tl] | (1u << bit); const int cnt = __builtin_popcountll(__ballot(key[tl] >= cand)); if (cnt >= 16) prefix[tl] = cand; }
            }
#pragma unroll
            for (int tl = 0; tl < 8; ++tl) {
                const unsigned long long gt = __ballot(key[tl] > prefix[tl]), eq = __ballot(key[tl] == prefix[tl]);
                const int need = 16 - __builtin_popcountll(gt);
                const int below = __builtin_popcountll(eq & ((1ull << j) - 1ull));
                const unsigned long long mk = gt | __ballot(key[tl] == prefix[tl] && below < need);
                wsel |= mk; if (tl == (r32 >> 2)) mysel = mk;
            }
        }
        LAS unsigned* uni = (LAS unsigned*)(lds + L_UNI);
        if (tid < 2) uni[tid] = 0u;
        __syncthreads();
        if (lane == 0) { __hip_atomic_fetch_or(uni, (unsigned)wsel, __ATOMIC_RELAXED, __HIP_MEMORY_SCOPE_WORKGROUP); __hip_atomic_fetch_or(uni + 1, (unsigned)(wsel >> 32), __ATOMIC_RELAXED, __HIP_MEMORY_SCOPE_WORKGROUP); }
        __syncthreads();
    }
    bf16_t* zrow = pbuf + (rowbase + tpos) * N_INP + N_Z + (4 * g + (r32 & 3)) * 64 + 8 * hi;
    u32x4 zz[2][2];
    {
        const LAS unsigned* uni = (const LAS unsigned*)(lds + L_UNI);
        const unsigned long long usel = ((unsigned long long)uni[1] << 32) | uni[0];
        const unsigned long long call = (c == 63) ? ~0ull : ((1ull << (c + 1)) - 1ull);
        for (int br = 0; br < 2; ++br) {
            if (br == 1) {
#pragma unroll
                for (int d0 = 0; d0 < 2; ++d0)
#pragma unroll
                    for (int gp = 0; gp < 2; ++gp) zz[d0][gp] = *(const u32x4*)(zrow + d0 * 32 + gp * 16); }
            unsigned long long tm = br == 0 ? (usel & call) : (call & ~((c >= 9) ? ((1ull << (c - 8)) - 1ull) : 0ull));
            const int koffc = br == 0 ? N_KS : N_KW, voffc = br == 0 ? N_VS : N_VW;
            f32x16 o[2] = {}; m_reg = -1e30f; l_reg = 0.f;
            bool wact, selok; hi_lim = tpos; lo_lim = br == 0 ? -(1 << 30) : tpos - 511;
#define SETLIM() do { selok = br != 0 || ((mysel >> cur) & 1ull); wact = br != 0 || ((wsel >> cur) & 1ull); } while (0)
            int cur = __builtin_ctzll(tm); tm &= tm - 1;
            if (br != 0) STAGE_SW(cur, 0, koffc, voffc);
            __syncthreads();
            for (;;) {
                int nxt = tm ? __builtin_ctzll(tm) : -1; tm &= tm - 1;
                if (nxt >= 0) STAGE_SW(nxt, 1, koffc, voffc);
                SETLIM();
                TILE64(2, 0, cur * 64, o, wact, selok);
                __syncthreads();
                cur = nxt; if (cur < 0) break;
                nxt = tm ? __builtin_ctzll(tm) : -1; tm &= tm - 1;
                if (nxt >= 0) STAGE_SW(nxt, 0, koffc, voffc);
                SETLIM();
                TILE64(2, 1, cur * 64, o, wact, selok);
                __syncthreads();
                cur = nxt; if (cur < 0) break;
            }
            { const float gr = (br == 0 ? gate[1] : gate[2]) * (l_reg > 0.f ? 1.f / l_reg : 0.f);
#pragma unroll
              for (int r = 0; r < 16; ++r) { acc[0][r] += o[0][r] * gr; acc[1][r] += o[1][r] * gr; } }
        }
#undef STAGE_SW
    }
    {
#pragma unroll
        for (int d0 = 0; d0 < 2; ++d0)
#pragma unroll
            for (int gp = 0; gp < 2; ++gp) {
                float ov[8], zf[8];
#pragma unroll
                for (int e = 0; e < 4; ++e) { auto rr = __builtin_amdgcn_permlane32_swap(__float_as_uint(acc[d0][8 * gp + e]), __float_as_uint(acc[d0][8 * gp + 4 + e]), false, false);
                    ov[e] = __uint_as_float(rr[0]); ov[4 + e] = __uint_as_float(rr[1]); }
                unpack8(zz[d0][gp], zf);
#pragma unroll
                for (int e = 0; e < 8; ++e) ov[e] = ov[e] * zf[e] / (1.f + __expf(-zf[e]));
                if (!dry) *(bf16x8*)(zrow + d0 * 32 + gp * 16) = pack8((f32x4){ov[0], ov[1], ov[2], ov[3]}, (f32x4){ov[4], ov[5], ov[6], ov[7]});
            }
    }
    __syncthreads();
#undef TILE64
#undef SETLIM
#undef Q_AND_GATES
#undef STAGE_K
#undef GLDS
}

__device__ __forceinline__ void phase_attn(Frame& F, int jl, int dry) {
    const int bx = blockIdx.x, vcu = (bx & 7) * (GRID / 8) + (bx >> 3);
    if (F.wave >= 4) __builtin_amdgcn_s_setprio(1);
    for (int it = 0; it < 2; ++it) {
        const int item = vcu * 2 + it, bg = item >> 5, s = item & 31;
        for (int pass = 0; pass < 2; ++pass) attn_unit(F, jl, bg >> 2, bg & 3, pass ? s : 63 - s, dry);
    }
    __builtin_amdgcn_s_setprio(0);
}
}

__global__ void __launch_bounds__(NWAVES * 64, 2) mk_fwd(Args args) {
    extern __shared__ __attribute__((aligned(16))) unsigned char lds_raw[];
    Frame F;
    F.lds = (LAS unsigned char*)lds_raw;
    F.tid = threadIdx.x; F.lane = F.tid & 63; F.wave = __builtin_amdgcn_readfirstlane(F.tid >> 6); F.G = gridDim.x;
    F.in = args.in; F.out = args.out; F.ws = args.ws;
    volatile LAS unsigned* MISC = (volatile LAS unsigned*)(F.lds + MISC_OFF);
    if (F.tid < 128) ((LAS unsigned*)(F.lds + LDSCTL_OFF))[F.tid] = 0u;
    __syncthreads();
    const int lo = args.ph_lo, hi = args.ph_hi;
    XcdBarrier bar; bar.bar = (unsigned*)(F.ws + WS_CTL) + CW_BAR; bar.x = 0; bar.st = nullptr;
    if (hi - lo > 1) bar = xcd_barrier_post((unsigned*)(F.ws + WS_CTL) + CW_BAR, MISC + 8);
    for (int ph = lo; ph < hi; ++ph) {
        const PhaseDesc pd = decode_phase(ph);
        { int t_ = threadIdx.x; asm volatile("" : "+v"(t_)); F.tid = t_; F.lane = t_ & 63; }
        { unsigned char* w_ = args.ws; float* o_ = args.out; asm volatile("" : "+s"(w_), "+s"(o_)); F.ws = w_; F.out = o_; }
        const int dry = args.dry;
        switch (pd.kind) {
        case K_PROLOGUE: pro::phase_prologue(F); break;
        case K_MLA_G1: case K_MLA_G2: case K_NSA_G1: {
            if (pd.kind == K_MLA_G2) phase_kpes(F, pd.j);
            pg8::Gemm g; pg8::EpiBf16RS E;
            if (pd.kind == K_MLA_G1) { const MlaW w = mla_w(F.ws, pd.j); g = pg8::Gemm{F.xb(), w.win, T, M_INP, 1024, DM}; E = pg8::EpiBf16RS{F.p1(), M_INP, F.ssqx(), 4, 1.f / 1024.f, dry >= 2 ? dry - 1 : 0, F.ssq1(), 1, F.lds + RING_OFF, nullptr, 0}; }
            else if (pd.kind == K_NSA_G1) { const NsaW w = nsa_w(F.ws, pd.j); g = pg8::Gemm{F.xb(), w.win, T, N_INP, 1024, DM}; E = pg8::EpiBf16RS{F.p1(), N_INP, F.ssqx(), 4, 1.f / 1024.f, dry >= 2 ? dry - 1 : 0, nullptr, 0, F.lds + RING_OFF, nullptr, 0}; }
            else { const MlaW w = mla_w(F.ws, pd.j); g = pg8::Gemm{F.p1() + M_CKV, w.wukv, T, 4096, 256, M_INP};
                   E = pg8::EpiBf16RS{F.kvh(), 2048, F.ssq1() + (size_t)12 * T, 8, 1.f / 256.f, dry >= 2 ? dry - 1 : 0, F.ssqkn(), 2, F.lds + RING_OFF, F.kvh2(), 8}; }
            pg8::OrderRS S; S.init(g.M, g.N, F.G, (int)blockIdx.x); S.rs_ssq = E.rs_ssq; S.rs_nslot = E.rs_nslot; S.lds = F.lds + RING_OFF;
            pg8::gemm_phase<pg8::EpiBf16RS, pg8::OrderRS, true, true>(F.lds + RING_OFF, g, S, E);
        } break;
        case K_OUT: {
            pg8::Gemm g;
            if ((pd.L & 1) == 0) { const MlaW w = mla_w(F.ws, pd.j); g = pg8::Gemm{F.p1() + M_Z, w.wout, T, DM, 2048, M_INP}; }
            else { const NsaW w = nsa_w(F.ws, pd.j); g = pg8::Gemm{F.p1() + N_Z, w.wout, T, DM, 1024, N_INP}; }
            pg8::EpiResid E{pd.L == 0 ? F.f(I_X) : nullptr, F.xb(), pd.L == 3 ? F.out : nullptr, F.ssqx(), dry};
            pg8::StaticOrder S; S.init(T, DM, F.G, (int)blockIdx.x);
            pg8::gemm_phase<pg8::EpiResid, pg8::StaticOrder, false, true>(F.lds + RING_OFF, g, S, E);
        } break;
        case K_MLA_ATT: mla::phase_attn(F, pd.j, dry); break;
        case K_NSA_POST: nsap::phase_post(F, pd.j, dry); break;
        case K_NSA_ATT: nsa::phase_attn(F, pd.j, dry); break;
        default: break;
        }
        if (ph + 1 < hi) xcd_barrier(bar);
    }
}
extern "C" void kernel_launch(void* const* d_in, const int* in_sizes, int n_in, void* d_out, int out_size, void* d_ws, size_t ws_size, hipStream_t stream) {
    if (n_in != N_INPUTS || in_sizes[I_X] != T * DM || out_size != T * DM || ws_size < 256 * MiB) { fprintf(stderr, "kernel_launch: unexpected shapes (n_in %d, out %d, ws %zu); nothing launched\n", n_in, out_size, ws_size); return; }
    static bool attr_done = false;
    if (!attr_done) { attr_done = true;
        if (hipFuncSetAttribute((const void*)mk_fwd, hipFuncAttributeMaxDynamicSharedMemorySize, LDS_BYTES) != hipSuccess) fprintf(stderr, "kernel_launch: hipFuncSetAttribute(%d B LDS) failed\n", LDS_BYTES); }
    (void)hipMemsetAsync((char*)d_ws + WS_CTL, 0, 1 * MiB, stream);
    Args a{};
    for (int i = 0; i < N_INPUTS; ++i) a.in[i] = d_in[i];
    a.out = (float*)d_out; a.ws = (unsigned char*)d_ws; a.ph_lo = 0; a.ph_hi = N_PHASES; a.dry = 0; a.pad = 0;
    hipLaunchKernelGGL(mk_fwd, dim3(GRID), dim3(NWAVES * 64), LDS_BYTES, stream, a);
    const hipError_t le = hipPeekAtLastError();
    if (le != hipSuccess) fprintf(stderr, "kernel_launch: launch failed: %s\n", hipGetErrorName(le));
}
```

```cpp
#include <hip/hip_runtime.h>
#include <stdint.h>
#include <stdio.h>

typedef unsigned short bf16_t;

constexpr int T = 16384, DM = 1024, NB = 4, SEQ = 4096;
constexpr float EPS = 1e-6f;
constexpr int M_INP = 2816, M_IN = 2752, M_CKV = 384, M_KPE = 640, M_Z = 704;
constexpr int N_INP = 4608, N_IN = 4528;
constexpr int N_Q = 0, N_KC = 1536, N_VC = 1920, N_KS = 2176, N_VS = 2560, N_KW = 2816, N_VW = 3200, N_GL = 3456, N_Z = 3504;
constexpr int NCMP = 255;
constexpr float LOG2E = 1.4426950408889634f;
constexpr float M_SCL2 = 0.07216878364870322f * LOG2E;
constexpr float N_SCL2 = 0.10206207261596575f * LOG2E;

constexpr size_t MiB = 1u << 20;
constexpr size_t WS_CTL = 0;
constexpr size_t WS_COSM = 1 * MiB, WS_SINM = 3 * MiB;
constexpr size_t WS_COSN = 5 * MiB, WS_SINN = 6 * MiB;
constexpr size_t WS_BIAS = 7 * MiB - 4096;
constexpr size_t WS_SSQX = 7 * MiB;
constexpr size_t WS_SSQ1 = 8 * MiB;
constexpr size_t WS_SSQKN = 252 * MiB;
constexpr size_t WS_KPES = 12 * MiB;
constexpr size_t WS_KCMP = 14 * MiB;
constexpr size_t WS_VCMP = 15 * MiB;
constexpr size_t WS_W = 16 * MiB;
constexpr size_t WSZ_MLA = (size_t)(2816 * 1024 + 3072 * 384 + 4096 * 256 + 1024 * 2048) * 2;
constexpr size_t WSZ_NSA = (size_t)(4608 * 1024 + 96 * 3072 + 96 * 96 + 64 * 2048 + 64 * 64 + 1024 * 1024) * 2;
constexpr size_t WS_XB = 68 * MiB;
constexpr size_t WS_P1 = 100 * MiB;
constexpr size_t WS_KVH = 188 * MiB;
static_assert(WS_W + 2 * (WSZ_MLA + WSZ_NSA) <= WS_XB, "weights fit");

struct MlaW { bf16_t *win, *wuq, *wukv, *wout; };
struct NsaW { bf16_t *win, *w1k, *w2k, *w1v, *w2v, *wout; float *bk, *bv; };
__host__ __device__ inline MlaW mla_w(unsigned char* ws, int j) {
    bf16_t* p = (bf16_t*)(ws + WS_W + (size_t)j * (WSZ_MLA + WSZ_NSA));
    MlaW w; w.win = p; w.wuq = w.win + 2816 * 1024; w.wukv = w.wuq + 3072 * 384; w.wout = w.wukv + 4096 * 256; return w;
}
__host__ __device__ inline NsaW nsa_w(unsigned char* ws, int j) {
    bf16_t* p = (bf16_t*)(ws + WS_W + (size_t)j * (WSZ_MLA + WSZ_NSA) + WSZ_MLA);
    NsaW w; w.win = p; w.w1k = w.win + 4608 * 1024; w.w2k = w.w1k + 96 * 3072; w.w1v = w.w2k + 96 * 96; w.w2v = w.w1v + 64 * 2048; w.wout = w.w2v + 64 * 64;
    w.bk = (float*)(ws + WS_BIAS) + j * 160; w.bv = w.bk + 96; return w;
}

enum { I_X = 0, I_POS, I_NORMG, I_MWIN, I_MGCQ, I_MWUQ, I_MGCKV, I_MWUKV, I_MGQ, I_MGK, I_MWOUT,
       I_NWIN, I_NGQ, I_NGK, I_NPEK, I_NW1K, I_NW2K, I_NPEV, I_NW1V, I_NW2V, I_NWOUT, N_INPUTS };

__device__ __forceinline__ float bf2f(bf16_t v) { return __uint_as_float((unsigned)v << 16); }
__device__ __forceinline__ bf16_t f2bf(float f) { unsigned u = __float_as_uint(f); return (bf16_t)((u + 0x7fffu + ((u >> 16) & 1u)) >> 16); }
template <int CTRL> __device__ __forceinline__ float dppf(float x) { return __int_as_float(__builtin_amdgcn_update_dpp(0, __float_as_int(x), CTRL, 0xf, 0xf, false)); }
__device__ __forceinline__ float get_xor1(float x) { return dppf<0xB1>(x); }
__device__ __forceinline__ float get_xor2(float x) { return dppf<0x4E>(x); }
__device__ __forceinline__ float sum_xor16(float x) { auto r = __builtin_amdgcn_permlane16_swap(__float_as_uint(x), __float_as_uint(x), false, false); return __uint_as_float(r[0]) + __uint_as_float(r[1]); }
__device__ __forceinline__ float sum_xor32(float x) { auto r = __builtin_amdgcn_permlane32_swap(__float_as_uint(x), __float_as_uint(x), false, false); return __uint_as_float(r[0]) + __uint_as_float(r[1]); }
__device__ __forceinline__ float get_xor32(float x, int hi) { auto r = __builtin_amdgcn_permlane32_swap(__float_as_uint(x), __float_as_uint(x), false, false); return __uint_as_float(hi ? r[0] : r[1]); }
__device__ __forceinline__ float wave_sum(float v) {
    v += get_xor1(v); v += get_xor2(v); v += dppf<0x124>(v); v += dppf<0x128>(v);
    return sum_xor32(sum_xor16(v));
}

__constant__ float c_invf32[32] = {1.000000000e+00f, 6.636012793e-01f, 4.403665960e-01f, 2.922278047e-01f, 1.939227432e-01f, 1.286873668e-01f, 8.539710194e-02f, 5.666962266e-02f, 3.760603070e-02f, 2.495540865e-02f, 1.656043902e-02f, 1.098952908e-02f, 7.292664610e-03f, 4.839421250e-03f, 3.211445874e-03f, 2.131119603e-03f, 1.414213562e-03f, 9.384738514e-04f, 6.227723788e-04f, 4.132725589e-04f, 2.742481884e-04f, 1.819914323e-04f, 1.207697351e-04f, 8.014294872e-05f, 5.318296098e-05f, 3.529227615e-05f, 2.341999971e-05f, 1.554154005e-05f, 1.031338616e-05f, 6.843975370e-06f, 4.541670478e-06f, 3.013858077e-06f};
__constant__ float c_invf12[12] = {1.000000000e+00f, 3.350316584e-01f, 1.122462004e-01f, 3.760603070e-02f, 1.259920839e-02f, 4.221134819e-03f, 1.414213562e-03f, 4.738064308e-04f, 1.587400620e-04f, 5.318296098e-05f, 1.781797801e-05f, 5.969583526e-06f};
#define GAS __attribute__((address_space(1)))
#define LAS __attribute__((address_space(3)))
typedef unsigned v4u __attribute__((ext_vector_type(4)));
typedef float f32x4 __attribute__((ext_vector_type(4)));
typedef short bf16x8 __attribute__((ext_vector_type(8)));
typedef GAS unsigned gu32;
typedef GAS unsigned long long gu64;
#define RLX_AGENT __ATOMIC_RELAXED, __HIP_MEMORY_SCOPE_AGENT
#define LDS_WAIT() asm volatile("s_waitcnt lgkmcnt(0)" ::: "memory")
#define VM_WAIT() asm volatile("s_waitcnt vmcnt(0)" ::: "memory")
__device__ __forceinline__ unsigned long long rt() { return __builtin_amdgcn_s_memrealtime(); }
__device__ __forceinline__ unsigned pk2(float lo, float hi) { return (unsigned)f2bf(lo) | ((unsigned)f2bf(hi) << 16); }

#define XB_TMO      128
#define XB_XCNT(j)  (256  + 64 * (j))
#define XB_XSUB(j)  (1280 + 64 * (j))
#define XB_XGEN(j)  (2304 + 64 * (j))
#define XB_TOP      3328
#define XB_TOPGEN   3392
#define XCD_BAR_WORDS 3456
#define XB_SPIN_CAP (1u << 18)

__device__ __forceinline__ unsigned xb_ld(unsigned* p)              { return __hip_atomic_load(p, __ATOMIC_RELAXED, __HIP_MEMORY_SCOPE_AGENT); }
__device__ __forceinline__ unsigned xb_add(unsigned* p, unsigned v) { return __hip_atomic_fetch_add(p, v, __ATOMIC_RELAXED, __HIP_MEMORY_SCOPE_AGENT); }
__device__ __forceinline__ unsigned xb_xcc_id() { return (unsigned)__builtin_amdgcn_s_getreg((3 << 11) | 20) & 0xFu; }
#define XB_SPIN(cond, bar) do { unsigned _sp = 0; while (cond) { __builtin_amdgcn_s_sleep(1); \
    if ((++_sp & 255u) == 0u) { if (xb_ld(&(bar)[XB_TMO])) break; if (_sp > XB_SPIN_CAP) { atomicAdd(&(bar)[XB_TMO], 1u); break; } } } } while (0)

struct XcdBarrier {
    unsigned* bar; unsigned x;
    volatile LAS unsigned* st;
};

__device__ __forceinline__ XcdBarrier xcd_barrier_post(unsigned* bar, volatile LAS unsigned* st) {
    XcdBarrier b; b.bar = bar; b.x = xb_xcc_id(); b.st = st;
    if (threadIdx.x == 0) (void)xb_add(&bar[XB_XCNT(b.x)], 1u);
    return b;
}
__device__ __forceinline__ void xcd_barrier_complete(unsigned* bar, unsigned x, unsigned& nloc, unsigned& nx) {
    const unsigned G = gridDim.x * gridDim.y * gridDim.z;
    unsigned sum, cnt, mine, sp = 0u;
    for (;;) {
        sum = 0u; cnt = 0u; mine = 0u;
#pragma unroll
        for (unsigned j = 0; j < 16; ++j) { const unsigned c = xb_ld(&bar[XB_XCNT(j)]); sum += c; cnt += (c > 0u) ? 1u : 0u; mine = (j == x) ? c : mine; }
        if (sum == G) break;
        __builtin_amdgcn_s_sleep(1);
        if ((++sp & 255u) == 0u) { if (xb_ld(&bar[XB_TMO])) break; if (sp > XB_SPIN_CAP) { atomicAdd(&bar[XB_TMO], 1u); break; } }
    }
    nloc = mine > 0u ? mine : 1u; nx = cnt > 0u ? cnt : 1u;
}

__device__ __forceinline__ void xcd_barrier(const XcdBarrier& b) {
    asm volatile("s_waitcnt vmcnt(0)" ::: "memory");
    __syncthreads();
    if (threadIdx.x == 0) {
        unsigned* bar = b.bar;
        __builtin_amdgcn_s_waitcnt(0);
        unsigned nloc = b.st[0], nx = b.st[1];
        if (nloc == 0u) { xcd_barrier_complete(bar, b.x, nloc, nx); b.st[0] = nloc; b.st[1] = nx; }
        const unsigned old = xb_add(&bar[XB_XSUB(b.x)], 1u);
        const unsigned gen = old / nloc;
        if (old + 1u == (gen + 1u) * nloc) {
            __builtin_amdgcn_fence(__ATOMIC_RELEASE, "agent");
            asm volatile("s_waitcnt vmcnt(0)" ::: "memory");
            const unsigned og = xb_add(&bar[XB_TOP], 1u);
            const unsigned tg = og / nx;
            if (og + 1u == (tg + 1u) * nx) xb_add(&bar[XB_TOPGEN], 1u);
            else XB_SPIN(xb_ld(&bar[XB_TOPGEN]) == tg, bar);
            __builtin_amdgcn_fence(__ATOMIC_ACQUIRE, "agent");
            xb_add(&bar[XB_XGEN(b.x)], 1u);
            asm volatile("s_waitcnt vmcnt(0)" ::: "memory");
        } else {
            XB_SPIN(xb_ld(&bar[XB_XGEN(b.x)]) == gen, bar);
            __builtin_amdgcn_fence(__ATOMIC_ACQUIRE, "agent");
            asm volatile("s_waitcnt vmcnt(0)" ::: "memory");
        }
    }
    __syncthreads();
}
namespace pg8 {
#define PG8_LAS __attribute__((address_space(3)))
typedef short bf16x8 __attribute__((ext_vector_type(8)));
typedef float f32x4 __attribute__((ext_vector_type(4)));
typedef unsigned u32x4 __attribute__((ext_vector_type(4)));
constexpr int BM = 256, BK = 64, HALF = 128, HTB = HALF * BK * 2  , STAGE_BYTES = 8 * HTB, NXCD = 8, WGM = 8;

__host__ __device__ __forceinline__ int lds_byte(int r, int c) { const int st = (r >> 4) * 2 + (c >> 5), rr = r & 15, cc = c & 31, ob = rr * 64 + cc * 2; return st * 1024 + (ob ^ (((ob >> 9) & 1) << 5)); }
__host__ __device__ __forceinline__ void stage_rc(int b, int& R, int& C) { const int st = b / 1024, sb = b % 1024, swz = sb ^ (((sb >> 9) & 1) << 5); R = (st >> 1) * 16 + swz / 64; C = (st & 1) * 32 + (swz % 64) / 2; }
__host__ __device__ __forceinline__ int perm32(int rho) { const int n = rho >> 4, i = rho & 15; return 8 * (i >> 2) + 4 * n + (i & 3); }

struct Unit { int pm, pn; };
struct Gemm { const bf16_t* A; const bf16_t* Bt; int M, N, K, lda; };

struct StaticOrder {
    int nM, nN, nwg, G, c;
    __host__ __device__ void init(int M, int N, int G_, int c_) { nM = M / BM; nN = N / BM; nwg = nM * nN; G = G_; c = c_; }
    __host__ __device__ bool next(int i, Unit& u) const {
        const long L = (long)i * G + c; if (L >= nwg) return false;
        int wgid = (int)L; { const int q = nwg / NXCD, r = nwg % NXCD, xcd = wgid % NXCD, off = wgid / NXCD; wgid = (xcd < r ? xcd * (q + 1) : r * (q + 1) + (xcd - r) * q) + off; }
        const int nig = WGM * nN, gid = wgid / nig, fm = gid * WGM, gsz = (nM - fm) < WGM ? (nM - fm) : WGM;
        u.pm = fm + ((wgid % nig) % gsz); u.pn = (wgid % nig) / gsz; return true;
    }
    __device__ __forceinline__ void a_ready(const Unit&, int) const {}
    __device__ __forceinline__ void done(const Unit&) const {}
};

template <class Epi, class Sched, bool ALIGN_EPI = false, bool SP2 = false>
__device__ __forceinline__ void gemm_phase(PG8_LAS unsigned char* lds, const Gemm g, const Sched& S, const Epi& E) {
    int tid_ = threadIdx.x; asm volatile("" : "+v"(tid_));
    const int tid = tid_, wid = __builtin_amdgcn_readfirstlane(tid >> 6), lane = tid & 63, wr = wid >> 2, wc = wid & 3, fr = lane & 15, fq = lane >> 4;
    const int K = g.K, nt = K / BK;
    unsigned voffA[2], voffB[2];
#pragma unroll
    for (int i = 0; i < 2; ++i) { int R, C; stage_rc(tid * 16 + i * 8192, R, C); const int Rb = Epi::PERM ? ((R & ~31) + perm32(R & 31)) : R;
        voffA[i] = (unsigned)(R * g.lda + C) * 2u; voffB[i] = (unsigned)(Rb * K + C) * 2u; }
    const size_t kstep = (size_t)(BK * 2);
    const size_t hstepA = (size_t)HALF * g.lda * 2, hstepB = (size_t)HALF * K * 2;
    const size_t tstepA = 2 * hstepA, tstepB = 2 * hstepB;
    const unsigned ldsw = (unsigned)wid * 1024u;
    const int aoff = lds_byte(wr * 64 + fr, fq * 8), boff = lds_byte(wc * 32 + fr, fq * 8);
#define PG8_SA(b, h) (((b) * 2 + (h)) * HTB)
#define PG8_SB(b, h) ((4 + (b) * 2 + (h)) * HTB)
#define PG8_STAGE(bufoff, gbase, voff) do { _Pragma("unroll") for (int _i = 0; _i < 2; ++_i) \
        __builtin_amdgcn_global_load_lds((const unsigned*)((const char*)(gbase) + (voff)[_i]), (PG8_LAS unsigned*)(lds + (bufoff) + ldsw + _i * 8192), 16, 0, 0); } while (0)
#define PG8_LDA(dst, b, h) do { _Pragma("unroll") for (int m = 0; m < 4; ++m) _Pragma("unroll") for (int k = 0; k < 2; ++k) dst[m][k] = *(const PG8_LAS bf16x8*)(lds + PG8_SA(b, h) + aoff + m * 2048 + k * 1024); } while (0)
#define PG8_LDB(dst, b, h) do { _Pragma("unroll") for (int n = 0; n < 2; ++n) _Pragma("unroll") for (int k = 0; k < 2; ++k) dst[n][k] = *(const PG8_LAS bf16x8*)(lds + PG8_SB(b, h) + boff + n * 2048 + k * 1024); } while (0)
#define PG8_MMA(ai, bj, At, Bt) do { __builtin_amdgcn_s_setprio(1); _Pragma("unroll") for (int m = 0; m < 4; ++m) _Pragma("unroll") for (int n = 0; n < 2; ++n) _Pragma("unroll") for (int k = 0; k < 2; ++k) \
        acc[ai][bj][m][n] = __builtin_amdgcn_mfma_f32_16x16x32_bf16(Bt[n][k], At[m][k], acc[ai][bj][m][n], 0, 0, 0); __builtin_amdgcn_s_setprio(0); } while (0)
#define PG8_WAIT_V(n) asm volatile("s_waitcnt vmcnt(" #n ")" ::: "memory")
#define PG8_WAIT_L(n) asm volatile("s_waitcnt lgkmcnt(" #n ")" ::: "memory")
#define PG8_BAR __builtin_amdgcn_s_barrier()
#define PG8_SCHED __builtin_amdgcn_sched_barrier(0)
    Unit cur, nxt; int ui = 0;
    if (!S.next(0, cur)) return;
    f32x4 acc[2][2][4][2];
#pragma unroll
    for (int a = 0; a < 2; ++a)
#pragma unroll
        for (int b = 0; b < 2; ++b)
#pragma unroll
            for (int m = 0; m < 4; ++m)
#pragma unroll
                for (int n = 0; n < 2; ++n) acc[a][b][m][n] = (f32x4){0.f, 0.f, 0.f, 0.f};
    bf16x8 At[4][2], B0[2][2], B1[2][2];
    const char* cA = (const char*)g.A + (size_t)cur.pm * tstepA; const char* cB = (const char*)g.Bt + (size_t)cur.pn * tstepB;
    S.a_ready(cur, ui);
    if constexpr (SP2) {
        PG8_STAGE(PG8_SB(0, 0), cB, voffB); PG8_STAGE(PG8_SB(0, 1), cB + hstepB, voffB); PG8_STAGE(PG8_SA(0, 0), cA, voffA); PG8_STAGE(PG8_SA(0, 1), cA + hstepA, voffA);
        if (wr == 1) PG8_BAR;
        PG8_WAIT_V(0); PG8_BAR;
        PG8_STAGE(PG8_SB(1, 0), cB + kstep, voffB); PG8_STAGE(PG8_SB(1, 1), cB + hstepB + kstep, voffB);
        PG8_BAR;
    } else {
        PG8_STAGE(PG8_SB(0, 0), cB, voffB); PG8_STAGE(PG8_SA(0, 0), cA, voffA); PG8_STAGE(PG8_SB(0, 1), cB + hstepB, voffB); PG8_STAGE(PG8_SA(0, 1), cA + hstepA, voffA);
        if (wr == 1) PG8_BAR;
        PG8_WAIT_V(4); PG8_BAR;
        PG8_STAGE(PG8_SB(1, 0), cB + kstep, voffB); PG8_STAGE(PG8_SA(1, 0), cA + kstep, voffA); PG8_STAGE(PG8_SB(1, 1), cB + hstepB + kstep, voffB);
        PG8_WAIT_V(6); PG8_BAR;
    }
    for (;;) {
        const bool has_next = S.next(ui + 1, nxt);
        const char* nA = has_next ? (const char*)g.A + (size_t)nxt.pm * tstepA : cA; const char* nB = has_next ? (const char*)g.Bt + (size_t)nxt.pn * tstepB : cB;
        for (int t = 0; t < nt; t += 2) {
            const bool last = (t == nt - 2);
            const char* a1 = cA + (size_t)(t + 1) * kstep;
            const char* a2 = last ? nA : cA + (size_t)(t + 2) * kstep; const char* b2 = last ? nB : cB + (size_t)(t + 2) * kstep;
            const char* a3 = a2 + kstep; const char* b3 = b2 + kstep;
            if (last && has_next) S.a_ready(nxt, ui + 1);
            if constexpr (SP2) {
            PG8_LDB(B0, 0, 0); PG8_LDB(B1, 0, 1); PG8_SCHED; PG8_LDA(At, 0, 0); PG8_STAGE(PG8_SA(1, 0), a1, voffA); PG8_STAGE(PG8_SA(1, 1), a1 + hstepA, voffA);
            PG8_WAIT_V(8); PG8_WAIT_L(0); PG8_BAR; PG8_MMA(0, 0, At, B0); PG8_MMA(0, 1, At, B1); PG8_BAR; PG8_SCHED;
            PG8_LDA(At, 0, 1); PG8_STAGE(PG8_SB(0, 0), b2, voffB); PG8_STAGE(PG8_SB(0, 1), b2 + hstepB, voffB);
            PG8_WAIT_V(4); PG8_WAIT_L(0); PG8_BAR; PG8_MMA(1, 0, At, B0); PG8_MMA(1, 1, At, B1); PG8_BAR; PG8_SCHED;
            PG8_LDB(B0, 1, 0); PG8_LDB(B1, 1, 1); PG8_SCHED; PG8_LDA(At, 1, 0); PG8_STAGE(PG8_SA(0, 0), a2, voffA); PG8_STAGE(PG8_SA(0, 1), a2 + hstepA, voffA);
            PG8_WAIT_V(8); PG8_WAIT_L(0); PG8_BAR; PG8_MMA(0, 0, At, B0); PG8_MMA(0, 1, At, B1); PG8_BAR; PG8_SCHED;
            PG8_LDA(At, 1, 1); PG8_STAGE(PG8_SB(1, 0), b3, voffB); PG8_STAGE(PG8_SB(1, 1), b3 + hstepB, voffB);
            PG8_WAIT_V(4); PG8_WAIT_L(0); PG8_BAR; PG8_MMA(1, 0, At, B0); PG8_MMA(1, 1, At, B1); PG8_BAR; PG8_SCHED;
            } else {
            PG8_LDB(B0, 0, 0); PG8_SCHED; PG8_LDA(At, 0, 0); PG8_STAGE(PG8_SA(1, 1), a1 + hstepA, voffA);
            PG8_WAIT_L(8); PG8_BAR; PG8_WAIT_L(0); PG8_MMA(0, 0, At, B0); PG8_BAR; PG8_SCHED;
            PG8_LDB(B1, 0, 1); PG8_STAGE(PG8_SB(0, 0), b2, voffB);
            PG8_BAR; PG8_WAIT_L(0); PG8_MMA(0, 1, At, B1); PG8_BAR;
            PG8_LDA(At, 0, 1); PG8_STAGE(PG8_SA(0, 0), a2, voffA);
            PG8_BAR; PG8_WAIT_L(0); PG8_MMA(1, 0, At, B0); PG8_BAR; PG8_SCHED;
            PG8_STAGE(PG8_SB(0, 1), b2 + hstepB, voffB);
            PG8_WAIT_V(6); PG8_BAR; PG8_MMA(1, 1, At, B1); PG8_BAR;
            PG8_LDB(B0, 1, 0); PG8_SCHED; PG8_LDA(At, 1, 0); PG8_STAGE(PG8_SA(0, 1), a2 + hstepA, voffA);
            PG8_WAIT_L(8); PG8_BAR; PG8_WAIT_L(0); PG8_MMA(0, 0, At, B0); PG8_BAR; PG8_SCHED;
            PG8_LDB(B1, 1, 1); PG8_STAGE(PG8_SB(1, 0), b3, voffB);
            PG8_BAR; PG8_WAIT_L(0); PG8_MMA(0, 1, At, B1); PG8_BAR;
            PG8_LDA(At, 1, 1); PG8_STAGE(PG8_SA(1, 0), a3, voffA);
            PG8_BAR; PG8_WAIT_L(0); PG8_MMA(1, 0, At, B0); PG8_BAR; PG8_SCHED;
            PG8_STAGE(PG8_SB(1, 1), b3 + hstepB, voffB);
            PG8_WAIT_V(6); PG8_BAR; PG8_MMA(1, 1, At, B1); PG8_BAR;
            }
        }
        if constexpr (ALIGN_EPI) { if (wr == 0) PG8_BAR; }
        if constexpr (!Epi::AFTER_DRAIN) { E(acc, cur, wr, wc, fr, fq, ui, !has_next); S.done(cur); }
        if (!has_next) break;
#pragma unroll
        for (int a = 0; a < 2; ++a)
#pragma unroll
            for (int b = 0; b < 2; ++b)
#pragma unroll
                for (int m = 0; m < 4; ++m)
#pragma unroll
                    for (int n = 0; n < 2; ++n) acc[a][b][m][n] = (f32x4){0.f, 0.f, 0.f, 0.f};
        cur = nxt; cA = nA; cB = nB; ++ui;
        if constexpr (ALIGN_EPI) { if (wr == 1) PG8_BAR; }
    }
    PG8_WAIT_V(0);
    if constexpr (!ALIGN_EPI) { if (wr == 0) PG8_BAR; }
    PG8_BAR;
    if constexpr (Epi::AFTER_DRAIN) { E.fused(acc, cur, wr, wc, fr, fq, lds, wid, lane); S.done(cur); }
#undef PG8_SA
#undef PG8_SB
#undef PG8_STAGE
#undef PG8_LDA
#undef PG8_LDB
#undef PG8_MMA
#undef PG8_WAIT_V
#undef PG8_WAIT_L
#undef PG8_BAR
#undef PG8_SCHED
}
}
#ifndef PG8_PROBE_EPI
#define PG8_PROBE_EPI 0
#endif
namespace pg8 {
__device__ __forceinline__ unsigned cvt_pk_bf16(float lo, float hi) { unsigned r; asm volatile("v_cvt_pk_bf16_f32 %0, %1, %2" : "=v"(r) : "v"(lo), "v"(hi)); return r; }

constexpr int RS_LDS_OFF = STAGE_BYTES, RS_LDS_BUF = 8192;
struct OrderRS : StaticOrder {
    const float* rs_ssq; int rs_nslot; PG8_LAS unsigned char* lds;
    __device__ __forceinline__ void a_ready(const Unit& u, int ui) const {
        int tid_ = threadIdx.x; asm volatile("" : "+v"(tid_));
        const int wid = __builtin_amdgcn_readfirstlane(tid_ >> 6), lane = tid_ & 63;
        for (int i = wid; i < rs_nslot * 4; i += 8) { const int slot = i >> 2, rb = i & 3;
            __builtin_amdgcn_global_load_lds((const unsigned*)(rs_ssq + (size_t)slot * T + u.pm * BM + rb * 64 + lane),
                                             (PG8_LAS unsigned*)(lds + RS_LDS_OFF + (ui & 1) * RS_LDS_BUF + slot * 1024 + rb * 256), 4, 0, 0); }
    }
};
struct EpiBf16RS {
    static constexpr bool PERM = true, AFTER_DRAIN = false;
    bf16_t* O; int ldc;
    const float* rs_ssq; int rs_nslot; float rs_invn;
    int skip;
    float* ssq_out; int ssq_mode;
    PG8_LAS unsigned char* lds;
    bf16_t* O2; int split_pn;
    __device__ __forceinline__ void operator()(const f32x4 (&acc)[2][2][4][2], const Unit& u, int wr, int wc, int fr, int fq, int ui, bool last) const {
        if (PG8_PROBE_EPI && skip == 1) return;
        const int row0 = u.pm * BM + wr * 64 + fr, col0 = u.pn * BM + wc * 32 + 8 * fq;
        float scs[2][4];
        {
            const PG8_LAS float* rp0 = (const PG8_LAS float*)(lds + RS_LDS_OFF + (ui & 1) * RS_LDS_BUF) + wr * 64 + fr;
            if (rs_nslot == 8 && !(PG8_PROBE_EPI && skip == 3)) { float t[2][4][8];
#pragma unroll
                for (int ai = 0; ai < 2; ++ai)
#pragma unroll
                    for (int m = 0; m < 4; ++m)
#pragma unroll
                        for (int i = 0; i < 8; ++i) t[ai][m][i] = rp0[ai * HALF + m * 16 + i * 256];
#pragma unroll
                for (int ai = 0; ai < 2; ++ai)
#pragma unroll
                    for (int m = 0; m < 4; ++m) scs[ai][m] = ((t[ai][m][0] + t[ai][m][1]) + (t[ai][m][2] + t[ai][m][3])) + ((t[ai][m][4] + t[ai][m][5]) + (t[ai][m][6] + t[ai][m][7]));
            } else if (rs_nslot == 4 && !(PG8_PROBE_EPI && skip == 3)) { float t[2][4][4];
#pragma unroll
                for (int ai = 0; ai < 2; ++ai)
#pragma unroll
                    for (int m = 0; m < 4; ++m)
#pragma unroll
                        for (int i = 0; i < 4; ++i) t[ai][m][i] = rp0[ai * HALF + m * 16 + i * 256];
#pragma unroll
                for (int ai = 0; ai < 2; ++ai)
#pragma unroll
                    for (int m = 0; m < 4; ++m) scs[ai][m] = (t[ai][m][0] + t[ai][m][1]) + (t[ai][m][2] + t[ai][m][3]);
            } else {
#pragma unroll
                for (int ai = 0; ai < 2; ++ai)
#pragma unroll
                    for (int m = 0; m < 4; ++m) scs[ai][m] = 0.f;
            }
        }
#pragma unroll
        for (int ai = 0; ai < 2; ++ai)
#pragma unroll
            for (int m = 0; m < 4; ++m) {
                const int row = row0 + ai * HALF + m * 16;
                const float sc = rs_nslot ? rsqrtf(scs[ai][m] * rs_invn + EPS) : 1.f;
                bf16_t* rowp = (split_pn > 0 && u.pn >= split_pn) ? O2 + (size_t)row * ldc + (col0 - split_pn * BM) : O + (size_t)row * ldc + col0;
#pragma unroll
                for (int bj = 0; bj < 2; ++bj) {
                    const f32x4 v0 = acc[ai][bj][m][0] * sc, v1 = acc[ai][bj][m][1] * sc;
                    u32x4 w; w.x = cvt_pk_bf16(v0[0], v0[1]); w.y = cvt_pk_bf16(v0[2], v0[3]); w.z = cvt_pk_bf16(v1[0], v1[1]); w.w = cvt_pk_bf16(v1[2], v1[3]);
                    if (PG8_PROBE_EPI && skip == 2) asm volatile("" :: "v"(w));
                    else if (last) asm volatile("global_store_dwordx4 %0, %1, off sc1\n\ts_nop 1" :: "v"(rowp + bj * HALF), "v"(w) : "memory");
                    else *(u32x4*)(rowp + bj * HALF) = w;
                    const bool do_ssq = ssq_mode == 2 ? (bj == 0) : (ssq_mode == 1 && 8 * u.pn + 4 * bj + wc < 22);
                    if (do_ssq) {
                        float q = (v0[0] * v0[0] + v0[1] * v0[1]) + (v0[2] * v0[2] + v0[3] * v0[3]) + (v1[0] * v1[0] + v1[1] * v1[1]) + (v1[2] * v1[2] + v1[3] * v1[3]);
                        q = sum_xor32(sum_xor16(q));
                        if (fq == 0) {
                            if (ssq_mode == 1) ssq_out[(size_t)(8 * u.pn + 4 * bj + wc) * T + row] = q;
                            else ssq_out[(size_t)(u.pn * 4 + wc) * T + row] = q;
                        }
                    }
                }
            }
    }
};

struct EpiResid {
    static constexpr bool PERM = false, AFTER_DRAIN = true;
    const float* xf; bf16_t* xb; float* outf; float* ssqx; int dry;
    __device__ __forceinline__ void fused(f32x4 (&acc)[2][2][4][2], const Unit& u, int wr, int wc, int fr, int fq, PG8_LAS unsigned char* lds, int wid, int lane) const {
        typedef unsigned u32x2v __attribute__((ext_vector_type(2)));
        PG8_LAS float* P = (PG8_LAS float*)lds;
        const int col0 = u.pn * BM + wc * 32 + 4 * fq;
#pragma unroll
        for (int ai = 0; ai < 2; ++ai) {
            f32x4 res[4][2][2];
            if (xf) {
#pragma unroll
                for (int m = 0; m < 4; ++m) { const size_t rowoff = (size_t)(u.pm * BM + ai * HALF + wr * 64 + m * 16 + fr) * DM + col0;
#pragma unroll
                    for (int bj = 0; bj < 2; ++bj)
#pragma unroll
                        for (int n = 0; n < 2; ++n) res[m][bj][n] = *(const f32x4*)(xf + rowoff + bj * HALF + n * 16); }
            } else {
                u32x2v raw[4][2][2];
#pragma unroll
                for (int m = 0; m < 4; ++m) { const size_t rowoff = (size_t)(u.pm * BM + ai * HALF + wr * 64 + m * 16 + fr) * DM + col0;
#pragma unroll
                    for (int bj = 0; bj < 2; ++bj)
#pragma unroll
                        for (int n = 0; n < 2; ++n) raw[m][bj][n] = *(const u32x2v*)(xb + rowoff + bj * HALF + n * 16); }
#pragma unroll
                for (int m = 0; m < 4; ++m)
#pragma unroll
                    for (int bj = 0; bj < 2; ++bj)
#pragma unroll
                        for (int n = 0; n < 2; ++n) { const u32x2v w = raw[m][bj][n];
                            res[m][bj][n] = (f32x4){__uint_as_float(w.x << 16), __uint_as_float(w.x & 0xffff0000u), __uint_as_float(w.y << 16), __uint_as_float(w.y & 0xffff0000u)}; }
            }
#pragma unroll
            for (int m = 0; m < 4; ++m) {
                const int r = ai * HALF + wr * 64 + m * 16 + fr; const size_t rowoff = (size_t)(u.pm * BM + r) * DM + col0; float q = 0.f;
#pragma unroll
                for (int bj = 0; bj < 2; ++bj)
#pragma unroll
                    for (int n = 0; n < 2; ++n) {
                        const size_t off = rowoff + bj * HALF + n * 16;
                        const f32x4 v = res[m][bj][n] + acc[ai][bj][m][n];
                        if (dry) { q += v[0]; } else if (outf) *(f32x4*)(outf + off) = v;
                        else { u32x2v w; w.x = cvt_pk_bf16(v[0], v[1]); w.y = cvt_pk_bf16(v[2], v[3]); *(u32x2v*)(xb + off) = w;
                               const float a = __uint_as_float(w.x << 16), b = __uint_as_float(w.x & 0xffff0000u), c = __uint_as_float(w.y << 16), d = __uint_as_float(w.y & 0xffff0000u);
                               q += (a * a + b * b) + (c * c + d * d); }
                    }
                if (!outf) { q = sum_xor32(sum_xor16(q)); if (fq == 0) P[r * 4 + wc] = q; }
            }
        }
        if (!outf && !dry) {
            __syncthreads();
            const int t = wid * 64 + lane;
            if (t < 256) ssqx[(size_t)u.pn * T + u.pm * BM + t] = (P[t * 4 + 0] + P[t * 4 + 1]) + (P[t * 4 + 2] + P[t * 4 + 3]);
        }
    }
};
}
constexpr int NWAVES = 8;
constexpr int GRID = 256;
constexpr int LDS_BYTES = 163840;
constexpr int LDSCTL_OFF = 0, MISC_OFF = 320;
constexpr int RING_OFF = 512, RING_BYTES = LDS_BYTES - RING_OFF;
constexpr int CW_BAR = 4096;
constexpr int N_PHASES = 17;

enum PhaseKind { K_PROLOGUE = 0, K_MLA_G1, K_MLA_G2, K_MLA_ATT, K_OUT, K_NSA_G1, K_NSA_POST, K_NSA_ATT };
struct PhaseDesc { int kind, j, half, L; };
__host__ __device__ inline PhaseDesc decode_phase(int ph) {
    PhaseDesc d{K_PROLOGUE, 0, 0, 0}; if (ph == 0) return d;
    const int p = ph - 1; d.j = p / 8; const int r = p % 8;
    if (r < 4) { d.L = 2 * d.j; d.kind = r == 0 ? K_MLA_G1 : r == 1 ? K_MLA_G2 : r == 2 ? K_MLA_ATT : K_OUT; }
    else { d.L = 2 * d.j + 1; const int q = r - 4; d.kind = q == 0 ? K_NSA_G1 : q == 1 ? K_NSA_POST : q == 2 ? K_NSA_ATT : K_OUT; }
    return d;
}

struct Args { const void* in[N_INPUTS]; float* out; unsigned char* ws; int ph_lo, ph_hi, dry, pad; };

struct Frame {
    LAS unsigned char* lds; int tid, lane, wave, G;
    const void* const* in; float* out; unsigned char* ws;
    __device__ __forceinline__ const float* f(int i) const { return (const float*)in[i]; }
    __device__ __forceinline__ bf16_t* xb() const { return (bf16_t*)(ws + WS_XB); }
    __device__ __forceinline__ bf16_t* p1() const { return (bf16_t*)(ws + WS_P1); }
    __device__ __forceinline__ bf16_t* kvh() const { return (bf16_t*)(ws + WS_KVH); }
    __device__ __forceinline__ bf16_t* kvh2() const { return (bf16_t*)out; }
    __device__ __forceinline__ bf16_t* kpes() const { return (bf16_t*)(ws + WS_KPES); }
    __device__ __forceinline__ bf16_t* kcmp() const { return (bf16_t*)(ws + WS_KCMP); }
    __device__ __forceinline__ bf16_t* vcmp() const { return (bf16_t*)(ws + WS_VCMP); }
    __device__ __forceinline__ float* ssqx() const { return (float*)(ws + WS_SSQX); }
    __device__ __forceinline__ float* ssq1() const { return (float*)(ws + WS_SSQ1); }
    __device__ __forceinline__ float* ssqkn() const { return (float*)(ws + WS_SSQKN); }
    __device__ __forceinline__ float* cosM() const { return (float*)(ws + WS_COSM); }
    __device__ __forceinline__ float* sinM() const { return (float*)(ws + WS_SINM); }
    __device__ __forceinline__ float* cosN() const { return (float*)(ws + WS_COSN); }
    __device__ __forceinline__ float* sinN() const { return (float*)(ws + WS_SINN); }
};

__device__ __forceinline__ void phase_kpes(Frame& F, int j) {
    const bf16_t* p1 = F.p1(); const float* gk = F.f(I_MGK) + j * 192; const float* cosM = F.cosM(); const float* sinM = F.sinM(); bf16_t* kpes = F.kpes();
    constexpr int NTH = GRID * NWAVES * 64;
    float av[4], bv[4], cv[4], sv[4];
#pragma unroll
    for (int u = 0; u < 4; ++u) { const int i = blockIdx.x * (NWAVES * 64) + F.tid + u * NTH; const int t = i >> 5, f = i & 31;
        av[u] = bf2f(p1[(size_t)t * M_INP + M_KPE + f]) * gk[f]; bv[u] = bf2f(p1[(size_t)t * M_INP + M_KPE + 32 + f]) * gk[32 + f]; cv[u] = cosM[i]; sv[u] = sinM[i]; }
#pragma unroll
    for (int u = 0; u < 4; ++u) { const int i = blockIdx.x * (NWAVES * 64) + F.tid + u * NTH; const int t = i >> 5, f = i & 31;
        kpes[(size_t)t * 64 + f] = f2bf(av[u] * cv[u] - bv[u] * sv[u]); kpes[(size_t)t * 64 + 32 + f] = f2bf(bv[u] * cv[u] + av[u] * sv[u]); }
}
namespace pro {
__device__ __forceinline__ void sincos_rev(float ang, float& s, float& c) {
    double r = (double)ang * 0.15915494309189535; r -= floor(r);
    const float fr = (float)r; s = __builtin_amdgcn_sinf(fr); c = __builtin_amdgcn_cosf(fr);
}
__device__ __forceinline__ void transpose_item(const float* __restrict__ W, const float* __restrict__ g, bf16_t* __restrict__ WT, int K, int N, int Npad, int frag, LAS float* scr, int item, int lane) {
    const int nblk = Npad / 32, kb = item / nblk, nb = item - kb * nblk, k0 = 64 * kb, n0 = 32 * nb;
    float v[32];
#pragma unroll
    for (int i = 0; i < 32; ++i) { const int k = k0 + 2 * i + (lane >> 5), n = n0 + (lane & 31); v[i] = (k < K && n < N) ? W[(size_t)k * N + n] : 0.f; }
    if (g) {
#pragma unroll
        for (int i = 0; i < 32; ++i) { const int k = k0 + 2 * i + (lane >> 5); v[i] *= (k < K) ? g[k] : 0.f; } }
#pragma unroll
    for (int i = 0; i < 32; ++i) scr[(2 * i + (lane >> 5)) * 33 + (lane & 31)] = v[i];
    LDS_WAIT(); asm volatile("" ::: "memory");
    const int c = lane & 7;
    if (k0 + 8 * c < K) {
#pragma unroll
        for (int jj = 0; jj < 4; ++jj) { const int n = (lane >> 3) + 8 * jj; const LAS float* s = scr + (8 * c) * 33 + n;
            v4u o; o.x = pk2(s[0 * 33], s[1 * 33]); o.y = pk2(s[2 * 33], s[3 * 33]); o.z = pk2(s[4 * 33], s[5 * 33]); o.w = pk2(s[6 * 33], s[7 * 33]);
            if (frag == 0) *(v4u*)(WT + (size_t)(n0 + n) * K + k0 + 8 * c) = o;
            else { const int ka = k0 + 8 * c, l = ka / frag, rem = ka - l * frag, kk = rem >> 4, hf = (rem >> 3) & 1, nn = n0 + n, cb = nn >> 5, r = nn & 31;
                   *(v4u*)(WT + ((((size_t)l * (frag >> 4) + kk) * (frag >> 5) + cb) * 64 + hf * 32 + r) * 8) = o; } } }
    LDS_WAIT(); asm volatile("" ::: "memory");
}
struct TDesc { const float* W; const float* g; bf16_t* WT; int K, N, Npad, frag; };
__device__ __forceinline__ TDesc tdesc(Frame& F, int m) {
    const int j = m / 10, i = m % 10; const MlaW mw = mla_w(F.ws, j); const NsaW nw = nsa_w(F.ws, j);
    switch (i) {
    case 0: return TDesc{F.f(I_MWIN) + (size_t)j * 1024 * M_IN, F.f(I_NORMG) + (2 * j) * DM, mw.win, 1024, M_IN, M_INP, 0};
    case 1: return TDesc{F.f(I_MWUQ) + (size_t)j * 384 * 3072, F.f(I_MGCQ) + j * 384, mw.wuq, 384, 3072, 3072, 0};
    case 2: return TDesc{F.f(I_MWUKV) + (size_t)j * 256 * 4096, F.f(I_MGCKV) + j * 256, mw.wukv, 256, 4096, 4096, 0};
    case 3: return TDesc{F.f(I_MWOUT) + (size_t)j * 2048 * 1024, nullptr, mw.wout, 2048, 1024, 1024, 0};
    case 4: return TDesc{F.f(I_NWIN) + (size_t)j * 1024 * N_IN, F.f(I_NORMG) + (2 * j + 1) * DM, nw.win, 1024, N_IN, N_INP, 0};
    case 5: return TDesc{F.f(I_NW1K) + (size_t)j * 3072 * 96, nullptr, nw.w1k, 3072, 96, 96, 96};
    case 6: return TDesc{F.f(I_NW2K) + (size_t)j * 96 * 96, nullptr, nw.w2k, 96, 96, 96, 0};
    case 7: return TDesc{F.f(I_NW1V) + (size_t)j * 2048 * 64, nullptr, nw.w1v, 2048, 64, 64, 64};
    case 8: return TDesc{F.f(I_NW2V) + (size_t)j * 64 * 64, nullptr, nw.w2v, 64, 64, 64, 0};
    default: return TDesc{F.f(I_NWOUT) + (size_t)j * 1024 * 1024, nullptr, nw.wout, 1024, 1024, 1024, 0};
    }
}
__device__ __forceinline__ void phase_prologue(Frame& F) {
    const int tid = F.tid, lane = tid & 63, wid = __builtin_amdgcn_readfirstlane(tid >> 6);
    const int gw = blockIdx.x * NWAVES + wid, NGW = GRID * NWAVES;
    LAS float* scr = (LAS float*)(F.lds + RING_OFF + wid * 16384);
    { const float* x = F.f(I_X); bf16_t* xb = F.xb(); float* ssqx = F.ssqx();
      for (int m0 = 2 * gw; m0 < T; m0 += 2 * NGW) { f32x4 v[2][4];
#pragma unroll
          for (int rr = 0; rr < 2; ++rr)
#pragma unroll
              for (int jj = 0; jj < 4; ++jj) v[rr][jj] = ((const f32x4*)(x + (size_t)(m0 + rr) * DM) + lane)[64 * jj];
#pragma unroll
          for (int rr = 0; rr < 2; ++rr) { const int m = m0 + rr; unsigned long long* o8 = (unsigned long long*)(xb + (size_t)m * DM) + lane; float s = 0.f;
#pragma unroll
              for (int jj = 0; jj < 4; ++jj) { const f32x4 w = v[rr][jj]; const unsigned lo = pk2(w.x, w.y), hi2 = pk2(w.z, w.w); o8[64 * jj] = (unsigned long long)lo | ((unsigned long long)hi2 << 32);
                  const float a = __uint_as_float(lo << 16), b = __uint_as_float(lo & 0xffff0000u), c = __uint_as_float(hi2 << 16), d = __uint_as_float(hi2 & 0xffff0000u); s += (a * a + b * b) + (c * c + d * d); }
              s = wave_sum(s);
              if (lane == 0) { ssqx[m] = s; ssqx[T + m] = 0.f; ssqx[2 * T + m] = 0.f; ssqx[3 * T + m] = 0.f; } } } }
    { int cum = 0, next = gw;
      for (int m = 0; m < 20; ++m) { const TDesc d = tdesc(F, m); const int items = ((d.K + 63) / 64) * (d.Npad / 32);
          for (; next < cum + items; next += NGW) transpose_item(d.W, d.g, d.WT, d.K, d.N, d.Npad, d.frag, scr, next - cum, lane);
          cum += items; } }
    { const int* pos = (const int*)F.in[I_POS]; float* cM = F.cosM(); float* sM = F.sinM(); float* cN = F.cosN(); float* sN = F.sinN();
      constexpr int NTH = GRID * NWAVES * 64; const int i0 = blockIdx.x * (NWAVES * 64) + tid;
      static_assert(T * 32 == 4 * NTH && T * 12 <= 2 * NTH, "rope table partition");
      int pv[4]; float fv[4]; int pw[2]; float fw[2];
#pragma unroll
      for (int u = 0; u < 4; ++u) { const int i = i0 + u * NTH; pv[u] = pos[i >> 5]; fv[u] = c_invf32[i & 31]; }
#pragma unroll
      for (int u = 0; u < 2; ++u) { const int i = i0 + u * NTH, ic = i < T * 12 ? i : 0, t = ic / 12; pw[u] = pos[t]; fw[u] = c_invf12[ic - t * 12]; }
#pragma unroll
      for (int u = 0; u < 4; ++u) { const int i = i0 + u * NTH; float s, c; sincos_rev((float)pv[u] * fv[u], s, c); cM[i] = c; sM[i] = s; }
#pragma unroll
      for (int u = 0; u < 2; ++u) { const int i = i0 + u * NTH; if (i < T * 12) { float s, c; sincos_rev((float)pw[u] * fw[u], s, c); cN[i] = c; sN[i] = s; } } }
}
}
namespace att {
typedef short bf16x8 __attribute__((ext_vector_type(8)));
typedef short s16x4 __attribute__((ext_vector_type(4)));
typedef float f32x16 __attribute__((ext_vector_type(16)));
typedef float f32x4 __attribute__((ext_vector_type(4)));
typedef unsigned u32x4 __attribute__((ext_vector_type(4)));
#define SBAR() __builtin_amdgcn_sched_barrier(0)
__device__ __forceinline__ int crow(int r, int hi) { return (r & 3) + 8 * (r >> 2) + 4 * hi; }
__device__ __forceinline__ unsigned cvtpk(float lo, float hi) { unsigned r; asm volatile("v_cvt_pk_bf16_f32 %0, %1, %2" : "=v"(r) : "v"(lo), "v"(hi)); return r; }
__device__ __forceinline__ bf16x8 pack8(f32x4 a, f32x4 b) { u32x4 w = {cvtpk(a[0], a[1]), cvtpk(a[2], a[3]), cvtpk(b[0], b[1]), cvtpk(b[2], b[3])}; return __builtin_bit_cast(bf16x8, w); }
__device__ __forceinline__ void unpack8(u32x4 w, float* f) {
    f[0] = __uint_as_float(w.x << 16); f[1] = __uint_as_float(w.x & 0xffff0000u); f[2] = __uint_as_float(w.y << 16); f[3] = __uint_as_float(w.y & 0xffff0000u);
    f[4] = __uint_as_float(w.z << 16); f[5] = __uint_as_float(w.z & 0xffff0000u); f[6] = __uint_as_float(w.w << 16); f[7] = __uint_as_float(w.w & 0xffff0000u);
}
template <int NB32> __device__ __forceinline__ int v_st(int k, int c) { const int kk = (k & ~0xC) | ((k & 4) << 1) | ((k & 8) >> 1); return ((kk >> 3) * NB32 + (c >> 5)) * 512 + ((kk & 7) * 32 + (c & 31)) * 2; }
__device__ __forceinline__ int v_rd_base(int lane) { return ((lane & 3) << 3) | (((lane >> 2) & 3) << 6) | (((lane >> 4) & 1) << 5) | (((lane >> 5) & 1) << 8); }
__device__ __forceinline__ void softmax_tile(f32x16& p0, f32x16& p1, float& m_reg, float& l_reg, float& alpha, bf16x8& pa0, bf16x8& pa1, bf16x8& pa2, bf16x8& pa3) {
    float pmax = p0[0];
#pragma unroll
    for (int r = 1; r < 16; ++r) pmax = fmaxf(pmax, p0[r]);
#pragma unroll
    for (int r = 0; r < 16; ++r) pmax = fmaxf(pmax, p1[r]);
    { auto rr = __builtin_amdgcn_permlane32_swap(__float_as_uint(pmax), __float_as_uint(pmax), false, false); pmax = fmaxf(__uint_as_float(rr[0]), __uint_as_float(rr[1])); }
    const float mn = fmaxf(m_reg, pmax);
    alpha = __builtin_amdgcn_exp2f(m_reg - mn); m_reg = mn;
    float ps = 0.f;
#pragma unroll
    for (int r = 0; r < 16; ++r) { p0[r] = __builtin_amdgcn_exp2f(p0[r] - mn); ps += p0[r]; }
#pragma unroll
    for (int r = 0; r < 16; ++r) { p1[r] = __builtin_amdgcn_exp2f(p1[r] - mn); ps += p1[r]; }
    { auto rr = __builtin_amdgcn_permlane32_swap(__float_as_uint(ps), __float_as_uint(ps), false, false); ps = __uint_as_float(rr[0]) + __uint_as_float(rr[1]); }
    l_reg = l_reg * alpha + ps;
#define ATT_PK4(P, B_, OUT) do { unsigned a0 = cvtpk(P[B_ + 0], P[B_ + 1]), a1 = cvtpk(P[B_ + 2], P[B_ + 3]); unsigned b0 = cvtpk(P[B_ + 4], P[B_ + 5]), b1 = cvtpk(P[B_ + 6], P[B_ + 7]); \
        auto r0 = __builtin_amdgcn_permlane32_swap(a0, b0, false, false); auto r1 = __builtin_amdgcn_permlane32_swap(a1, b1, false, false); \
        u32x4 w = {r0[0], r1[0], r0[1], r1[1]}; OUT = __builtin_bit_cast(bf16x8, w); } while (0)
    ATT_PK4(p0, 0, pa0); ATT_PK4(p0, 8, pa1); ATT_PK4(p1, 0, pa2); ATT_PK4(p1, 8, pa3);
}
template <int NB32, int VOFF> __device__ __forceinline__ void pv_tile(f32x16* o, int vb, bf16x8 pa0, bf16x8 pa1, bf16x8 pa2, bf16x8 pa3) {
#define TRRD(dst, off) asm volatile("ds_read_b64_tr_b16 %0, %1 offset:%2" : "=&v"(dst) : "v"(vb), "i"(off) : "memory")
#pragma unroll
    for (int d0 = 0; d0 < NB32; ++d0) {
        s16x4 l0, l1, l2, l3, h0, h1, h2, h3; constexpr int KS = NB32 * 1024, HF = NB32 * 512;
#define TRR(dst, ks, hf) do { if (d0 == 0) TRRD(dst, VOFF + 0 * 512 + (ks) * KS + (hf) * HF); else if (d0 == 1) TRRD(dst, VOFF + 1 * 512 + (ks) * KS + (hf) * HF); \
                              else if (d0 == 2) TRRD(dst, VOFF + 2 * 512 + (ks) * KS + (hf) * HF); else TRRD(dst, VOFF + 3 * 512 + (ks) * KS + (hf) * HF); } while (0)
        TRR(l0, 0, 0); TRR(h0, 0, 1); TRR(l1, 1, 0); TRR(h1, 1, 1); TRR(l2, 2, 0); TRR(h2, 2, 1); TRR(l3, 3, 0); TRR(h3, 3, 1);
        asm volatile("s_waitcnt lgkmcnt(0)" ::: "memory"); SBAR();
        o[d0] = __builtin_amdgcn_mfma_f32_32x32x16_bf16(pa0, (bf16x8){l0[0], l0[1], l0[2], l0[3], h0[0], h0[1], h0[2], h0[3]}, o[d0], 0, 0, 0);
        o[d0] = __builtin_amdgcn_mfma_f32_32x32x16_bf16(pa1, (bf16x8){l1[0], l1[1], l1[2], l1[3], h1[0], h1[1], h1[2], h1[3]}, o[d0], 0, 0, 0);
        o[d0] = __builtin_amdgcn_mfma_f32_32x32x16_bf16(pa2, (bf16x8){l2[0], l2[1], l2[2], l2[3], h2[0], h2[1], h2[2], h2[3]}, o[d0], 0, 0, 0);
        o[d0] = __builtin_amdgcn_mfma_f32_32x32x16_bf16(pa3, (bf16x8){l3[0], l3[1], l3[2], l3[3], h3[0], h3[1], h3[2], h3[3]}, o[d0], 0, 0, 0);
#undef TRR
    }
#undef TRRD
}
constexpr float THR2 = 5.f;
__device__ __forceinline__ float max3f(float a, float b, float c) { return __builtin_fmaxf(__builtin_fmaxf(a, b), c); }
__device__ __forceinline__ void softmax_sub(f32x16& p, float& m_reg, float& l_reg, float& alpha, bool& resc, bf16x8& pa0, bf16x8& pa1) {
    float pa_ = max3f(p[0], p[1], p[2]), pb_ = max3f(p[3], p[4], p[5]);
    pa_ = max3f(pa_, p[6], p[7]); pb_ = max3f(pb_, p[8], p[9]); pa_ = max3f(pa_, p[10], p[11]); pb_ = max3f(pb_, p[12], p[13]); pa_ = max3f(pa_, p[14], p[15]);
    float pmax = __builtin_fmaxf(pa_, pb_);
    { auto rr = __builtin_amdgcn_permlane32_swap(__float_as_uint(pmax), __float_as_uint(pmax), false, false); pmax = __builtin_fmaxf(__uint_as_float(rr[0]), __uint_as_float(rr[1])); }
    resc = !__all(pmax - m_reg <= THR2);
    alpha = 1.f;
    if (resc) { const float mn = __builtin_fmaxf(m_reg, pmax); alpha = __builtin_amdgcn_exp2f(m_reg - mn); m_reg = mn; l_reg *= alpha; }
    const float mn2 = m_reg;
    float ps = 0.f;
#pragma unroll
    for (int r = 0; r < 16; ++r) { p[r] = __builtin_amdgcn_exp2f(p[r] - mn2); ps += p[r]; }
    { auto rr = __builtin_amdgcn_permlane32_swap(__float_as_uint(ps), __float_as_uint(ps), false, false); ps = __uint_as_float(rr[0]) + __uint_as_float(rr[1]); }
    l_reg += ps;
    ATT_PK4(p, 0, pa0); ATT_PK4(p, 8, pa1);
}
__device__ __forceinline__ void softmax64(f32x16& p0, f32x16& p1, float& m_reg, float& l_reg, float& alpha, bool& resc, bf16x8& pa0, bf16x8& pa1, bf16x8& pa2, bf16x8& pa3) {
    float xa = max3f(p0[0], p0[1], p0[2]), xb = max3f(p0[3], p0[4], p0[5]), xc = max3f(p1[0], p1[1], p1[2]), xd = max3f(p1[3], p1[4], p1[5]);
    xa = max3f(xa, p0[6], p0[7]); xb = max3f(xb, p0[8], p0[9]); xc = max3f(xc, p1[6], p1[7]); xd = max3f(xd, p1[8], p1[9]);
    xa = max3f(xa, p0[10], p0[11]); xb = max3f(xb, p0[12], p0[13]); xc = max3f(xc, p1[10], p1[11]); xd = max3f(xd, p1[12], p1[13]);
    xa = max3f(xa, p0[14], p0[15]); xc = max3f(xc, p1[14], p1[15]);
    float pmax = __builtin_fmaxf(__builtin_fmaxf(xa, xb), __builtin_fmaxf(xc, xd));
    { auto rr = __builtin_amdgcn_permlane32_swap(__float_as_uint(pmax), __float_as_uint(pmax), false, false); pmax = __builtin_fmaxf(__uint_as_float(rr[0]), __uint_as_float(rr[1])); }
    resc = !__all(pmax - m_reg <= THR2);
    alpha = 1.f;
    if (resc) { const float mn = __builtin_fmaxf(m_reg, pmax); alpha = __builtin_amdgcn_exp2f(m_reg - mn); m_reg = mn; l_reg *= alpha; }
    const float mn2 = m_reg;
    float s0 = 0.f, s1 = 0.f, s2 = 0.f, s3 = 0.f;
#pragma unroll
    for (int r = 0; r < 16; r += 2) { p0[r] = __builtin_amdgcn_exp2f(p0[r] - mn2); s0 += p0[r]; p0[r + 1] = __builtin_amdgcn_exp2f(p0[r + 1] - mn2); s1 += p0[r + 1]; }
#pragma unroll
    for (int r = 0; r < 16; r += 2) { p1[r] = __builtin_amdgcn_exp2f(p1[r] - mn2); s2 += p1[r]; p1[r + 1] = __builtin_amdgcn_exp2f(p1[r + 1] - mn2); s3 += p1[r + 1]; }
    float ps = (s0 + s1) + (s2 + s3);
    { auto rr = __builtin_amdgcn_permlane32_swap(__float_as_uint(ps), __float_as_uint(ps), false, false); ps = __uint_as_float(rr[0]) + __uint_as_float(rr[1]); }
    l_reg += ps;
    ATT_PK4(p0, 0, pa0); ATT_PK4(p0, 8, pa1); ATT_PK4(p1, 0, pa2); ATT_PK4(p1, 8, pa3);
}
__device__ __forceinline__ void softmax64_off(f32x16& p0, f32x16& p1, float c0, float& m_reg, float& l_reg, float& alpha, bool& resc, bf16x8& pa0, bf16x8& pa1, bf16x8& pa2, bf16x8& pa3) {
    float xa = max3f(p0[0], p0[1], p0[2]), xb = max3f(p0[3], p0[4], p0[5]), xc = max3f(p1[0], p1[1], p1[2]), xd = max3f(p1[3], p1[4], p1[5]);
    xa = max3f(xa, p0[6], p0[7]); xb = max3f(xb, p0[8], p0[9]); xc = max3f(xc, p1[6], p1[7]); xd = max3f(xd, p1[8], p1[9]);
    xa = max3f(xa, p0[10], p0[11]); xb = max3f(xb, p0[12], p0[13]); xc = max3f(xc, p1[10], p1[11]); xd = max3f(xd, p1[12], p1[13]);
    xa = max3f(xa, p0[14], p0[15]); xc = max3f(xc, p1[14], p1[15]);
    float pmax = __builtin_fmaxf(__builtin_fmaxf(xa, xb), __builtin_fmaxf(xc, xd));
    { auto rr = __builtin_amdgcn_permlane32_swap(__float_as_uint(pmax), __float_as_uint(pmax), false, false); pmax = __builtin_fmaxf(__uint_as_float(rr[0]), __uint_as_float(rr[1])); }
    resc = !__all((pmax + c0) - m_reg <= THR2);
    alpha = 1.f;
    if (resc) { const float mn = __builtin_fmaxf(m_reg, pmax + c0); alpha = __builtin_amdgcn_exp2f(m_reg - mn); m_reg = mn; l_reg *= alpha;
        const float sh = mn - c0;
#pragma unroll
        for (int r = 0; r < 16; ++r) { p0[r] -= sh; p1[r] -= sh; } }
    float s0 = 0.f, s1 = 0.f, s2 = 0.f, s3 = 0.f;
#pragma unroll
    for (int r = 0; r < 16; r += 2) { p0[r] = __builtin_amdgcn_exp2f(p0[r]); s0 += p0[r]; p0[r + 1] = __builtin_amdgcn_exp2f(p0[r + 1]); s1 += p0[r + 1]; }
#pragma unroll
    for (int r = 0; r < 16; r += 2) { p1[r] = __builtin_amdgcn_exp2f(p1[r]); s2 += p1[r]; p1[r + 1] = __builtin_amdgcn_exp2f(p1[r + 1]); s3 += p1[r + 1]; }
    float ps = (s0 + s1) + (s2 + s3);
    { auto rr = __builtin_amdgcn_permlane32_swap(__float_as_uint(ps), __float_as_uint(ps), false, false); ps = __uint_as_float(rr[0]) + __uint_as_float(rr[1]); }
    l_reg += ps;
    ATT_PK4(p0, 0, pa0); ATT_PK4(p0, 8, pa1); ATT_PK4(p1, 0, pa2); ATT_PK4(p1, 8, pa3);
}
template <int NB32> struct VFrag { s16x4 l0[NB32], h0[NB32], l1[NB32], h1[NB32]; };
template <int NB32, int VOFF> __device__ __forceinline__ void v_issue(VFrag<NB32>& f, int vb) {
#define TRRD(dst, off) asm volatile("ds_read_b64_tr_b16 %0, %1 offset:%2" : "=&v"(dst) : "v"(vb), "i"(off) : "memory")
    constexpr int KS = NB32 * 1024, HF = NB32 * 512;
#define VI_D0(D0) do { TRRD(f.l0[D0], VOFF + (D0) * 512); TRRD(f.h0[D0], VOFF + (D0) * 512 + HF); TRRD(f.l1[D0], VOFF + (D0) * 512 + KS); TRRD(f.h1[D0], VOFF + (D0) * 512 + KS + HF); } while (0)
    VI_D0(0); VI_D0(1); if constexpr (NB32 > 2) { VI_D0(2); VI_D0(3); }
#undef VI_D0
#undef TRRD
}
template <int NB32, bool SWAP = false> __device__ __forceinline__ void v_consume(f32x16* o, VFrag<NB32>& f, bf16x8 pa0, bf16x8 pa1) {
    asm volatile("s_waitcnt lgkmcnt(0)" : "+v"(f.l0[0]), "+v"(f.h0[0]), "+v"(f.l1[0]), "+v"(f.h1[0]), "+v"(f.l0[1]), "+v"(f.h0[1]), "+v"(f.l1[1]), "+v"(f.h1[1]) :: "memory");
    if constexpr (NB32 > 2) asm volatile("" : "+v"(f.l0[2]), "+v"(f.h0[2]), "+v"(f.l1[2]), "+v"(f.h1[2]), "+v"(f.l0[3]), "+v"(f.h0[3]), "+v"(f.l1[3]), "+v"(f.h1[3]));
    SBAR();
#pragma unroll
    for (int d0 = 0; d0 < NB32; ++d0) {
        const bf16x8 v0 = {f.l0[d0][0], f.l0[d0][1], f.l0[d0][2], f.l0[d0][3], f.h0[d0][0], f.h0[d0][1], f.h0[d0][2], f.h0[d0][3]};
        const bf16x8 v1 = {f.l1[d0][0], f.l1[d0][1], f.l1[d0][2], f.l1[d0][3], f.h1[d0][0], f.h1[d0][1], f.h1[d0][2], f.h1[d0][3]};
        if constexpr (SWAP) { o[d0] = __builtin_amdgcn_mfma_f32_32x32x16_bf16(v0, pa0, o[d0], 0, 0, 0); o[d0] = __builtin_amdgcn_mfma_f32_32x32x16_bf16(v1, pa1, o[d0], 0, 0, 0); }
        else { o[d0] = __builtin_amdgcn_mfma_f32_32x32x16_bf16(pa0, v0, o[d0], 0, 0, 0); o[d0] = __builtin_amdgcn_mfma_f32_32x32x16_bf16(pa1, v1, o[d0], 0, 0, 0); }
    }
}
}

#define MLA_VAR 0
#define NSA_VAR 0
namespace mla {
using namespace att;
constexpr int KP = 400, KT = 64 * KP, VT = 64 * 128 * 2;
constexpr int L_K = 0, L_V = 2 * KT, L_KS = L_V + 2 * VT, L_WS = L_KS + SEQ * 4, L_G = L_WS + NWAVES * 256, L_END = L_G + 2 * 192 * 4;
static_assert(L_END <= RING_BYTES, "MLA attention LDS");


__device__ __forceinline__ void attn_unit(Frame& F, int j, int b, int h, int qb, int dry, bool prestaged, int h_next) {
    int tid_ = F.tid; asm volatile("" : "+v"(tid_));
    const int tid = tid_, lane = tid & 63, wid = __builtin_amdgcn_readfirstlane(tid >> 6), r32 = lane & 31, hi = lane >> 5;
    const int hl = h & 7;
    const size_t rowbase = (size_t)b * SEQ; const int q0 = qb * 256;
    const bf16_t* kvh = h < 8 ? F.kvh() : F.kvh2(); const bf16_t* kpes = F.kpes(); bf16_t* pbuf = F.p1();
    const float* ssq1 = F.ssq1();
    LAS unsigned char* lds = F.lds + RING_OFF;
    LAS float* wsf = (LAS float*)(lds + L_WS) + wid * 64;
    const int NT = 4 * qb + 4;
    const int qlo = q0 + wid * 32, qpos = qlo + r32;
    const unsigned char* kpes_b = (const unsigned char*)(kpes + rowbase * 64);
    const unsigned char* kvh_b = (const unsigned char*)(kvh + rowbase * 2048 + hl * 256);
    int koff[4]; unsigned kpe_mask = 0u; int voff[2];
#define GLDS(src, dst) __builtin_amdgcn_global_load_lds((const unsigned*)(src), (LAS unsigned*)(dst), 16, 0, 0)
#define STAGE_DMA(t, buf) do { const size_t ko = (size_t)(t) * 64; \
        _Pragma("unroll") for (int i = 0; i < 4; ++i) if (wid + 8 * i < 25) { \
            const unsigned char* sp_ = ((kpe_mask >> i) & 1u) ? kpes_b + ko * 128 + koff[i] : kvh_b + ko * 4096 + koff[i]; \
            GLDS(sp_, lds + L_K + (buf) * KT + (wid + 8 * i) * 1024); } \
        _Pragma("unroll") for (int i = 0; i < 2; ++i) GLDS(kvh_b + ko * 4096 + voff[i], lds + L_V + (buf) * VT + (wid + 8 * i) * 1024); } while (0)
    bf16x8 qr[12];
    {
        const size_t qrow = rowbase + qpos;
        constexpr int WP = 208, WCH = 192 * WP;
        const unsigned char* wsrc = (const unsigned char*)(mla_w(F.ws, j).wuq + (size_t)h * 192 * 384);
#define STAGE_W(src, c, bi) do { int lane_ = lane; asm volatile("" : "+v"(lane_)); _Pragma("unroll") for (int i = 0; i < 5; ++i) if (wid + 8 * i < 39) { \
            const int x_ = (wid + 8 * i) * 64 + lane_; const int wr_ = x_ / 13; int wc_ = x_ - wr_ * 13; if (wc_ == 12) wc_ = 11; \
            GLDS((src) + (size_t)wr_ * 768 + (c) * 192 + wc_ * 16, lds + (bi) * WCH + (wid + 8 * i) * 1024); } } while (0)
        if (!prestaged) { STAGE_W(wsrc, 0, 0); STAGE_W(wsrc, 1, 1); }
        const bf16_t* cqp = pbuf + qrow * M_INP + hi * 8;
        u32x4 cqa[6], cqb[6]; float sl[12];
#pragma unroll
        for (int ks = 0; ks < 6; ++ks) { cqa[ks] = *(const u32x4*)(cqp + ks * 16); cqb[ks] = *(const u32x4*)(cqp + (6 + ks) * 16); }
#pragma unroll
        for (int s = 0; s < 12; ++s) sl[s] = ssq1[(size_t)s * T + qrow];
        f32x16 qa[6] = {};
        const LAS unsigned char* wbase = lds + r32 * WP + hi * 16;
#define QMMA(c, CQ) do { bf16x8 wf_[2][6]; \
            _Pragma("unroll") for (int blk = 0; blk < 6; ++blk) wf_[0][blk] = *(const LAS bf16x8*)(wbase + ((c) & 1) * WCH + blk * 32 * WP); \
            _Pragma("unroll") for (int i = 0; i < 6; ++i) { \
                if (i + 1 < 6) { _Pragma("unroll") for (int blk = 0; blk < 6; ++blk) wf_[(i + 1) & 1][blk] = *(const LAS bf16x8*)(wbase + ((c) & 1) * WCH + blk * 32 * WP + (i + 1) * 32); } \
                SBAR(); \
                _Pragma("unroll") for (int blk = 0; blk < 6; ++blk) qa[blk] = __builtin_amdgcn_mfma_f32_32x32x16_bf16(wf_[i & 1][blk], __builtin_bit_cast(bf16x8, CQ[i]), qa[blk], 0, 0, 0); \
                SBAR(); } } while (0)
#define BAR_RAW() do { asm volatile("s_waitcnt lgkmcnt(0)" ::: "memory"); __builtin_amdgcn_s_barrier(); asm volatile("" ::: "memory"); } while (0)
        __syncthreads();
        float sscq = 0.f;
#pragma unroll
        for (int s = 0; s < 12; ++s) sscq += sl[s];
        QMMA(0, cqa);
        BAR_RAW();
        STAGE_W(wsrc, 2, 0);
#pragma unroll
        for (int ks = 0; ks < 6; ++ks) cqa[ks] = *(const u32x4*)(cqp + (12 + ks) * 16);
        QMMA(1, cqb);
        BAR_RAW();
        STAGE_W(wsrc, 3, 1);
#pragma unroll
        for (int ks = 0; ks < 6; ++ks) cqb[ks] = *(const u32x4*)(cqp + (18 + ks) * 16);
        if (wid < 7) asm volatile("s_waitcnt vmcnt(11)" ::: "memory"); else asm volatile("s_waitcnt vmcnt(10)" ::: "memory");
        BAR_RAW();
        QMMA(2, cqa);
        asm volatile("s_waitcnt vmcnt(0)" ::: "memory");
        BAR_RAW();
        f32x4 csv[4], snv[4];
        { const float* cp = F.cosM() + qrow * 32 + 4 * hi; const float* sp = F.sinM() + qrow * 32 + 4 * hi;
#pragma unroll
          for (int g4 = 0; g4 < 4; ++g4) { csv[g4] = *(const f32x4*)(cp + 8 * g4); snv[g4] = *(const f32x4*)(sp + 8 * g4); } }
        QMMA(3, cqb);
#undef QMMA
        __syncthreads();
        { int lane_ = lane; asm volatile("" : "+v"(lane_));
#pragma unroll
          for (int i = 0; i < 4; ++i) { const int x = (wid + 8 * i) * 64 + lane_; const int row = x / 25; int ch = x - row * 25; if (ch == 24) ch = 23;
              if (ch < 8) { kpe_mask |= 1u << i; koff[i] = row * 128 + ch * 16; } else koff[i] = row * 4096 + (ch - 8) * 16; }
#pragma unroll
          for (int i = 0; i < 2; ++i) { const int x = (wid + 8 * i) * 64 + lane_; const int sub = x >> 5, within = x & 31; const int kk = (sub >> 2) * 8 + (within >> 2);
              const int k = (kk & ~0xC) | ((kk & 4) << 1) | ((kk & 8) >> 1); voff[i] = k * 4096 + 256 + ((sub & 3) * 32 + (within & 3) * 8) * 2; } }
        STAGE_DMA(0, 0);
        const LAS float* gql = (const LAS float*)(lds + L_G); const LAS float* gkl = gql + 192;
        float ss = 0.f;
#pragma unroll
        for (int blk = 0; blk < 6; ++blk)
#pragma unroll
            for (int r = 0; r < 16; ++r) ss += qa[blk][r] * qa[blk][r];
        ss = sum_xor32(ss);
        const float a = rsqrtf(sscq * (1.f / 384.f) + EPS);
        const float sc = a * rsqrtf(a * a * ss * (1.f / 192.f) + EPS) * M_SCL2;
#pragma unroll
        for (int g4 = 0; g4 < 4; ++g4) {
            const f32x4 cs = csv[g4], sn = snv[g4];
            const f32x4 g1 = *(const LAS f32x4*)(gql + 8 * g4 + 4 * hi), g2 = *(const LAS f32x4*)(gql + 32 + 8 * g4 + 4 * hi);
#pragma unroll
            for (int e = 0; e < 4; ++e) { const int r = 4 * g4 + e; const float u = qa[0][r] * sc * g1[e], v = qa[1][r] * sc * g2[e];
                qa[0][r] = u * cs[e] - v * sn[e]; qa[1][r] = v * cs[e] + u * sn[e]; } }
#pragma unroll
        for (int blk = 2; blk < 6; ++blk) { f32x4 gg[4];
#pragma unroll
            for (int g4 = 0; g4 < 4; ++g4) gg[g4] = *(const LAS f32x4*)(gkl + 32 * blk + 8 * g4 + 4 * hi);
#pragma unroll
            for (int g4 = 0; g4 < 4; ++g4)
#pragma unroll
                for (int e = 0; e < 4; ++e) qa[blk][4 * g4 + e] *= sc * gg[g4][e]; }
#pragma unroll
        for (int d0 = 0; d0 < 12; ++d0) { if (d0 & 1) ATT_PK4(qa[d0 >> 1], 8, qr[d0]); else ATT_PK4(qa[d0 >> 1], 0, qr[d0]); }
    }
    __syncthreads();
    float m_reg = -1e30f, l_reg = 0.f; f32x16 o[4] = {};
    const LAS unsigned char* kbase = lds + L_K + r32 * KP + hi * 16;
    const LAS unsigned char* ksb = lds + L_KS + hi * 16;
    const int vb0 = (int)(uintptr_t)(lds + L_V) + v_rd_base(lane);
#define SUBTILE(BUF, t, SUB) do { const int kb0_ = (t) * 64 + 32 * (SUB); \
        if (kb0_ <= qlo + 31 && (MLA_VAR != 8 || wid < 4) && (MLA_VAR != 9 || (wid & 1) == 0)) { f32x16 p = {}; \
            if (MLA_VAR != 4) { bf16x8 kf_[12]; \
                _Pragma("unroll") for (int d0 = 0; d0 < 12; ++d0) kf_[d0] = *(const LAS bf16x8*)(kbase + (BUF) * KT + (SUB) * 32 * KP + d0 * 32); \
                SBAR(); \
                _Pragma("unroll") for (int d0 = 0; d0 < 12; ++d0) p = __builtin_amdgcn_mfma_f32_32x32x16_bf16(kf_[d0], qr[d0], p, 0, 0, 0); } \
            const LAS unsigned char* ksp_ = ksb + kb0_ * 4; \
            _Pragma("unroll") for (int g = 0; g < 4; ++g) { const f32x4 s0 = *(const LAS f32x4*)(ksp_ + g * 32); \
                _Pragma("unroll") for (int e = 0; e < 4; ++e) p[4 * g + e] *= s0[e]; } \
            if (kb0_ + 31 > qlo) { const float NEG = -__builtin_inff(); \
                _Pragma("unroll") for (int r = 0; r < 16; ++r) { if (kb0_ + crow(r, hi) > qpos) p[r] = NEG; } } \
            VFrag<4> vf; if (MLA_VAR != 3) v_issue<4, (BUF) * VT + 2 * (SUB) * 4096>(vf, vb0); \
            float alpha = 1.f; bool resc = false; bf16x8 pa0, pa1; \
            if (MLA_VAR != 2) softmax_sub(p, m_reg, l_reg, alpha, resc, pa0, pa1); else { pa0 = pack8((f32x4){p[0], p[1], p[2], p[3]}, (f32x4){p[4], p[5], p[6], p[7]}); pa1 = pack8((f32x4){p[8], p[9], p[10], p[11]}, (f32x4){p[12], p[13], p[14], p[15]}); } \
            if (resc) { _Pragma("unroll") for (int r = 0; r < 16; ++r) { o[0][r] *= alpha; o[1][r] *= alpha; o[2][r] *= alpha; o[3][r] *= alpha; } }     \
            v_consume<4, true>(o, vf, pa0, pa1); \
        } } while (0)
    for (int t = 0; t < ((MLA_VAR >= 10 && MLA_VAR <= 12) ? 0 : NT); t += 2) {
        if (wid < 4) STAGE_DMA(t + 1, 1);
        SUBTILE(0, t, 0);
        if (wid >= 4) STAGE_DMA(t + 1, 1);
        SUBTILE(0, t, 1);
        __syncthreads();
        if (t + 2 < NT && wid < 4) STAGE_DMA(t + 2, 0);
        SUBTILE(1, t + 1, 0);
        if (t + 2 < NT && wid >= 4) STAGE_DMA(t + 2, 0);
        SUBTILE(1, t + 1, 1);
        __syncthreads();
    }
    bf16_t* zrow = pbuf + (rowbase + qpos) * M_INP + M_Z + h * 128 + 8 * hi;
    u32x4 zz[4][2];
#pragma unroll
    for (int d0 = 0; d0 < 4; ++d0)
#pragma unroll
        for (int gp = 0; gp < 2; ++gp) zz[d0][gp] = *(const u32x4*)(zrow + d0 * 32 + gp * 16);
    if (h_next >= 0) {
        constexpr int WP = 208, WCH = 192 * WP;
        const unsigned char* wsrc = (const unsigned char*)(mla_w(F.ws, j).wuq + (size_t)h_next * 192 * 384);
        STAGE_W(wsrc, 0, 0); STAGE_W(wsrc, 1, 1);
    }
#undef STAGE_W
#undef BAR_RAW
    {
        const float rl = 1.f / l_reg;
#pragma unroll
        for (int d0 = 0; d0 < 4; ++d0)
#pragma unroll
            for (int gp = 0; gp < 2; ++gp) {
                float ov[8], zf[8];
#pragma unroll
                for (int e = 0; e < 4; ++e) { auto rr = __builtin_amdgcn_permlane32_swap(__float_as_uint(o[d0][8 * gp + e]), __float_as_uint(o[d0][8 * gp + 4 + e]), false, false);
                    ov[e] = __uint_as_float(rr[0]); ov[4 + e] = __uint_as_float(rr[1]); }
                unpack8(zz[d0][gp], zf);
#pragma unroll
                for (int e = 0; e < 8; ++e) ov[e] = ov[e] * rl * zf[e] / (1.f + __expf(-zf[e]));
                if (!dry) *(bf16x8*)(zrow + d0 * 32 + gp * 16) = pack8((f32x4){ov[0], ov[1], ov[2], ov[3]}, (f32x4){ov[4], ov[5], ov[6], ov[7]});
            }
    }
#undef STAGE_DMA
#undef GLDS
#undef SUBTILE
}

__device__ __forceinline__ void phase_attn(Frame& F, int j, int dry) {
    const int bx = blockIdx.x, vcu = (bx & 7) * (GRID / 8) + (bx >> 3);
    { LAS float* gl = (LAS float*)(F.lds + RING_OFF + L_G); const float* gq = F.f(I_MGQ) + j * 192; const float* gk = F.f(I_MGK) + j * 192;
      if (F.tid < 192) { const float g = gq[F.tid]; gl[F.tid] = g; gl[192 + F.tid] = g * gk[F.tid]; } }
    if (F.wave >= 4) __builtin_amdgcn_s_setprio(1);
    {
        constexpr int WP = 208, WCH = 192 * WP; const int h0 = (vcu >> 3) & 15, wid_ = F.wave, lane_ = F.tid & 63;
        const unsigned char* wsrc = (const unsigned char*)(mla_w(F.ws, j).wuq + (size_t)h0 * 192 * 384);
#pragma unroll
        for (int c = 0; c < 2; ++c)
#pragma unroll
            for (int i = 0; i < 5; ++i) if (wid_ + 8 * i < 39) { const int x_ = (wid_ + 8 * i) * 64 + lane_; const int wr_ = x_ / 13; int wc_ = x_ - wr_ * 13; if (wc_ == 12) wc_ = 11;
                __builtin_amdgcn_global_load_lds((const unsigned*)(wsrc + (size_t)wr_ * 768 + c * 192 + wc_ * 16), (LAS unsigned*)(F.lds + RING_OFF + c * WCH + (wid_ + 8 * i) * 1024), 16, 0, 0); }
    }
    for (int it = 0; it < 2; ++it) {
        const int item = it * GRID + vcu, bh = item >> 3, s = item & 7, b = bh >> 4, h = bh & 15;
        {
            const float* ssq1 = F.ssq1(); const float* ssqkn = F.ssqkn() + (size_t)h * 4 * T; LAS float* ksl = (LAS float*)(F.lds + RING_OFF + L_KS);
            const int nk = 256 * (16 - s);
            for (int k0 = 0; k0 < nk; k0 += 4 * NWAVES * 64) { float ssv[4];
#pragma unroll
                for (int u = 0; u < 4; ++u) { const int k = k0 + u * NWAVES * 64 + F.tid; const size_t kr = (size_t)b * SEQ + (k < nk ? k : 0);
                    ssv[u] = (ssq1[(size_t)20 * T + kr] + ssq1[(size_t)21 * T + kr]) + (ssqkn[kr] + ssqkn[T + kr]) + (ssqkn[2 * (size_t)T + kr] + ssqkn[3 * (size_t)T + kr]); }
#pragma unroll
                for (int u = 0; u < 4; ++u) { const int k = k0 + u * NWAVES * 64 + F.tid; if (k < nk) ksl[k] = rsqrtf(ssv[u] * (1.f / 192.f) + EPS); } }
        }
        const int h2 = (((it + 1) * GRID + vcu) >> 3) & 15;
        attn_unit(F, j, b, h, 15 - s, dry, true, h);
        attn_unit(F, j, b, h, s, dry, true, it == 0 ? h2 : -1);
    }
    __builtin_amdgcn_s_setprio(0);
}
}
namespace nsap {
using namespace att;
__device__ __forceinline__ void post_rows(Frame& F, int j, int dry) {
    int tid_ = F.tid; asm volatile("" : "+v"(tid_));
    const int tid = tid_, lane = tid & 63, wid = __builtin_amdgcn_readfirstlane(tid >> 6);
    bf16_t* pbuf = F.p1(); const float* gq = F.f(I_NGQ) + j * 96; const float* gk = F.f(I_NGK) + j * 288;
    const float* cosN = F.cosN(); const float* sinN = F.sinN();
    const int part = lane & 3;
    constexpr int NU = T * 8;
    for (int u0 = (blockIdx.x * NWAVES + wid) * 32 + (lane >> 2); u0 < NU; u0 += GRID * NWAVES * 32) {
        bf16_t* p[2]; const float* g[2]; float post[2]; int row[2]; float x[2][24];
#pragma unroll
        for (int k = 0; k < 2; ++k) { const int u = u0 + 16 * k; row[k] = u >> 3; const int un = u & 7;
            if (un < 4) { p[k] = pbuf + (size_t)row[k] * N_INP + N_KS + un * 96 + part * 24; g[k] = gk + 96 + part * 24; post[k] = 1.f; }
            else { p[k] = pbuf + (size_t)row[k] * N_INP + N_KW + (un - 4) * 96 + part * 24; g[k] = gk + 192 + part * 24; post[k] = 1.f; }
#pragma unroll
            for (int i = 0; i < 3; ++i) unpack8(*(const u32x4*)(p[k] + 8 * i), x[k] + 8 * i); }
#pragma unroll
        for (int k = 0; k < 2; ++k) { float ss = 0.f;
#pragma unroll
            for (int i = 0; i < 24; ++i) ss += x[k][i] * x[k][i];
            ss += get_xor1(ss); ss += get_xor2(ss);
            const float r = rsqrtf(ss * (1.f / 96.f) + EPS) * post[k];
#pragma unroll
            for (int i = 0; i < 24; ++i) x[k][i] *= r * g[k][i];
            if (part == 0) {
#pragma unroll
                for (int f = 0; f < 12; ++f) { const float c = cosN[row[k] * 12 + f], s = sinN[row[k] * 12 + f]; const float a = x[k][f], b2 = x[k][12 + f]; x[k][f] = a * c - b2 * s; x[k][12 + f] = b2 * c + a * s; } }
#pragma unroll
            for (int i = 0; i < 3; ++i) if (!dry) *(bf16x8*)(p[k] + 8 * i) = pack8((f32x4){x[k][8 * i], x[k][8 * i + 1], x[k][8 * i + 2], x[k][8 * i + 3]}, (f32x4){x[k][8 * i + 4], x[k][8 * i + 5], x[k][8 * i + 6], x[k][8 * i + 7]}); }
    }
}

constexpr int L_PART = 0, L_HID = 8 * 32 * 96 * 4, L_OUT = L_HID + 32 * 96 * 2, L_CEND = L_OUT + 32 * 96 * 4;
static_assert(L_CEND <= RING_BYTES, "compress LDS");
template <int DD>
__device__ __forceinline__ void compress_unit(Frame& F, int j, int b, int g, int nb) {
    int tid_ = F.tid; asm volatile("" : "+v"(tid_));
    const int tid = tid_, lane = tid & 63, wid = __builtin_amdgcn_readfirstlane(tid >> 6), r32 = lane & 31, hi = lane >> 5;
    constexpr int NC = DD / 32, KPT = DD / 16, KTOT = 32 * DD, COFF = DD == 96 ? N_KC : N_VC;
    const NsaW W = nsa_w(F.ws, j);
    const bf16_t* w1t = DD == 96 ? W.w1k : W.w1v; const bf16_t* w2t = DD == 96 ? W.w2k : W.w2v;
    const float* pe = (DD == 96 ? F.f(I_NPEK) + j * 32 * 96 : F.f(I_NPEV) + j * 32 * 64) + hi * 8;
    const bf16_t* pbuf = F.p1(); LAS unsigned char* lds = F.lds + RING_OFF;
    const size_t rowbase = (size_t)b * SEQ;
    int n = 32 * nb + r32; if (n > NCMP - 1) n = NCMP - 1;
    f32x16 acc[NC] = {};
#pragma unroll 1
    for (int li = 0; li < 4; ++li) {
        const int l = 4 * wid + li;
        const bf16_t* ap = pbuf + (rowbase + 16 * n + l) * N_INP + COFF + g * DD + hi * 8;
        u32x4 ar[KPT]; f32x4 p0[KPT], p1[KPT]; bf16x8 bb[KPT][NC];
#pragma unroll
        for (int kk = 0; kk < KPT; ++kk) { ar[kk] = *(const u32x4*)(ap + kk * 16); p0[kk] = *(const f32x4*)(pe + l * DD + kk * 16); p1[kk] = *(const f32x4*)(pe + l * DD + kk * 16 + 4);
#pragma unroll
            for (int cb = 0; cb < NC; ++cb) bb[kk][cb] = *(const bf16x8*)(w1t + ((((size_t)l * KPT + kk) * NC + cb) * 64 + lane) * 8); }
#pragma unroll
        for (int kk = 0; kk < KPT; ++kk) {
            float af[8]; unpack8(ar[kk], af);
            const bf16x8 a = pack8((f32x4){af[0] + p0[kk][0], af[1] + p0[kk][1], af[2] + p0[kk][2], af[3] + p0[kk][3]}, (f32x4){af[4] + p1[kk][0], af[5] + p1[kk][1], af[6] + p1[kk][2], af[7] + p1[kk][3]});
#pragma unroll
            for (int cb = 0; cb < NC; ++cb) acc[cb] = __builtin_amdgcn_mfma_f32_32x32x16_bf16(a, bb[kk][cb], acc[cb], 0, 0, 0);
        }
    }
    LAS float* part = (LAS float*)(lds + L_PART) + wid * 32 * DD;
#pragma unroll
    for (int cb = 0; cb < NC; ++cb)
#pragma unroll
        for (int r = 0; r < 16; ++r) part[crow(r, hi) * DD + cb * 32 + r32] = acc[cb][r];
    __syncthreads();
    LAS bf16_t* hid = (LAS bf16_t*)(lds + L_HID);
    for (int e = tid; e < 32 * DD; e += NWAVES * 64) { float t[8];
#pragma unroll
        for (int w = 0; w < 8; ++w) t[w] = ((LAS float*)(lds + L_PART))[w * 32 * DD + e];
        const float s = ((t[0] + t[1]) + (t[2] + t[3])) + ((t[4] + t[5]) + (t[6] + t[7]));
        hid[e] = f2bf(s / (1.f + __expf(-s))); }
    __syncthreads();
    LAS float* outl = (LAS float*)(lds + L_OUT);
    if (wid < NC) {
        f32x16 a2 = {};
        bf16x8 av[KPT], bv[KPT];
#pragma unroll
        for (int kk = 0; kk < KPT; ++kk) { bv[kk] = *(const bf16x8*)(w2t + (size_t)(wid * 32 + r32) * DD + kk * 16 + hi * 8); av[kk] = *(const LAS bf16x8*)(hid + r32 * DD + kk * 16 + hi * 8); }
#pragma unroll
        for (int kk = 0; kk < KPT; ++kk) a2 = __builtin_amdgcn_mfma_f32_32x32x16_bf16(av[kk], bv[kk], a2, 0, 0, 0);
#pragma unroll
        for (int r = 0; r < 16; ++r) outl[crow(r, hi) * DD + wid * 32 + r32] = a2[r];
    }
    __syncthreads();
    if constexpr (DD == 96) {
        if (tid < 128) {
            const int row = tid >> 2, prt = tid & 3, nn = 32 * nb + row;
            const float* g0 = F.f(I_NGK) + j * 288 + prt * 24;
            float x[24]; float ss = 0.f;
#pragma unroll
            for (int i = 0; i < 24; ++i) { x[i] = outl[row * 96 + prt * 24 + i]; ss += x[i] * x[i]; }
            ss += get_xor1(ss); ss += get_xor2(ss);
            const float r = rsqrtf(ss * (1.f / 96.f) + EPS);
#pragma unroll
            for (int i = 0; i < 24; ++i) x[i] *= r * g0[i];
            if (prt == 0) { const size_t tp = rowbase + 16 * nn + 31; const float* cp = F.cosN() + tp * 12; const float* sp = F.sinN() + tp * 12;
                if (nn < NCMP) {
#pragma unroll
                    for (int f = 0; f < 12; ++f) { const float c = cp[f], s = sp[f]; const float a = x[f], b2 = x[12 + f]; x[f] = a * c - b2 * s; x[12 + f] = b2 * c + a * s; } } }
            if (nn >= NCMP) {
#pragma unroll
                for (int i = 0; i < 24; ++i) x[i] = 0.f; }
            bf16_t* dst = F.kcmp() + (((size_t)b * 4 + g) * 256 + nn) * 96 + prt * 24;
#pragma unroll
            for (int i = 0; i < 3; ++i) *(bf16x8*)(dst + 8 * i) = pack8((f32x4){x[8 * i], x[8 * i + 1], x[8 * i + 2], x[8 * i + 3]}, (f32x4){x[8 * i + 4], x[8 * i + 5], x[8 * i + 6], x[8 * i + 7]});
        }
    } else {
        if (tid < 256) {
            const int row = tid >> 3, ch = tid & 7, nn = 32 * nb + row; float x[8];
#pragma unroll
            for (int i = 0; i < 8; ++i) x[i] = nn < NCMP ? outl[row * 64 + ch * 8 + i] : 0.f;
            *(bf16x8*)(F.vcmp() + (((size_t)b * 4 + g) * 256 + nn) * 64 + ch * 8) = pack8((f32x4){x[0], x[1], x[2], x[3]}, (f32x4){x[4], x[5], x[6], x[7]});
        }
    }
    __syncthreads();
}

__device__ __forceinline__ void phase_post(Frame& F, int j, int dry) {
    const int u = blockIdx.x;
    const int kind = u >> 7, r = u & 127, b = r >> 5, g = (r >> 3) & 3, nb = r & 7;
    if (kind == 0) compress_unit<96>(F, j, b, g, nb); else compress_unit<64>(F, j, b, g, nb);
    post_rows(F, j, dry);
}
}
namespace nsa {
using namespace att;
constexpr int KP = 208, KT = 64 * KP, VT = 16384;
constexpr int L_K = 0, L_V = 2 * KT, L_IMP = L_V + 2 * VT, L_SELM = L_IMP + 64 * 64 * 4, L_SCJ = L_SELM + 512, L_WS = L_SCJ + NWAVES * 256, L_GATE = L_WS + NWAVES * 256,
              L_UNI = L_GATE + NWAVES * 512, L_END = L_UNI + 16;
static_assert(L_END <= RING_BYTES, "NSA attention LDS");

__device__ __forceinline__ void attn_unit(Frame& F, int jl, int b, int g, int c, int dry) {
    int tid_ = F.tid; asm volatile("" : "+v"(tid_));
    const int tid = tid_, lane = tid & 63, wid = __builtin_amdgcn_readfirstlane(tid >> 6), r32 = lane & 31, hi = lane >> 5;
    LAS unsigned char* lds = F.lds + RING_OFF;
    bf16_t* pbuf = F.p1();
    const size_t rowbase = (size_t)b * SEQ;
    const int tpos = 64 * c + 8 * wid + (r32 >> 2);
    int krow[2], kch[2];
#pragma unroll
    for (int i = 0; i < 2; ++i) { const int x = (wid + 8 * i) * 64 + lane; krow[i] = x / 13; kch[i] = x - krow[i] * 13; if (kch[i] == 12) kch[i] = 11; }
    int vk2, vc2, vk4, vc4;
    { const int sub = wid * 2 + (lane >> 5), within = lane & 31; const int kk = (sub >> 1) * 8 + (within >> 2); vk2 = (kk & ~0xC) | ((kk & 4) << 1) | ((kk & 8) >> 1); vc2 = (sub & 1) * 32 + (within & 3) * 8; }
    { const int within = lane & 31; const int kk = wid * 8 + (within >> 2); vk4 = (kk & ~0xC) | ((kk & 4) << 1) | ((kk & 8) >> 1); vc4 = (lane >> 5) * 32 + (within & 3) * 8; }
#define GLDS(src, dst) __builtin_amdgcn_global_load_lds((const unsigned*)(src), (LAS unsigned*)(dst), 16, 0, 0)
#define STAGE_K(buf, kptr, kstride, row0) do { _Pragma("unroll") for (int i = 0; i < 2; ++i) if (wid + 8 * i < 13) \
        GLDS((const unsigned char*)(kptr) + (size_t)((row0) + krow[i]) * (kstride) + kch[i] * 16, lds + L_K + (buf) * KT + (wid + 8 * i) * 1024); } while (0)
    bf16x8 qr[6]; float gate[3];
#define Q_AND_GATES() do { \
    { const size_t qrow_ = rowbase + tpos; const bf16_t* qp = pbuf + qrow_ * N_INP + N_Q + (4 * g + (r32 & 3)) * 96 + hi * 8; \
      const float* gq_ = F.f(I_NGQ) + jl * 96 + hi * 8; const float* cp_ = F.cosN() + qrow_ * 12; const float* sp_ = F.sinN() + qrow_ * 12; \
      u32x4 raw_[6]; f32x4 gg_[6][2]; f32x4 cs_[3], sn_[3]; \
      for (int d0 = 0; d0 < 6; ++d0) { raw_[d0] = *(const u32x4*)(qp + d0 * 16); gg_[d0][0] = *(const f32x4*)(gq_ + d0 * 16); gg_[d0][1] = *(const f32x4*)(gq_ + d0 * 16 + 4); } \
      for (int i = 0; i < 3; ++i) { cs_[i] = *(const f32x4*)(cp_ + 4 * i); sn_[i] = *(const f32x4*)(sp_ + 4 * i); } \
      float x_[6][8]; float ss_ = 0.f; \
      for (int d0 = 0; d0 < 6; ++d0) { unpack8(raw_[d0], x_[d0]); for (int e = 0; e < 8; ++e) ss_ += x_[d0][e] * x_[d0][e]; } \
      ss_ = sum_xor32(ss_); \
      const float rn_ = rsqrtf(ss_ * (1.f / 96.f) + EPS) * N_SCL2; \
      for (int d0 = 0; d0 < 6; ++d0) for (int e = 0; e < 8; ++e) x_[d0][e] *= rn_ * gg_[d0][e >> 2][e & 3]; \
      float y0_[8], y1_[4]; \
      for (int e = 0; e < 8; ++e) y0_[e] = get_xor32(x_[0][e], hi);            \
      for (int e = 0; e < 4; ++e) y1_[e] = get_xor32(x_[1][4 + e], hi);        \
      if (hi == 0) { \
          for (int e = 0; e < 4; ++e) { const float a_ = x_[0][e], b_ = y0_[4 + e]; x_[0][e] = a_ * cs_[0][e] - b_ * sn_[0][e]; }                           \
          for (int e = 0; e < 4; ++e) { const float a_ = x_[0][4 + e], b_ = x_[1][e]; x_[0][4 + e] = a_ * cs_[1][e] - b_ * sn_[1][e]; x_[1][e] = b_ * cs_[1][e] + a_ * sn_[1][e]; }     \
          for (int e = 0; e < 4; ++e) { const float a_ = y0_[e], b_ = x_[1][4 + e]; x_[1][4 + e] = b_ * cs_[2][e] + a_ * sn_[2][e]; }                       \
      } else { \
          for (int e = 0; e < 4; ++e) { const float a_ = x_[0][e], b_ = y1_[e]; x_[0][e] = a_ * cs_[2][e] - b_ * sn_[2][e]; }                               \
          for (int e = 0; e < 4; ++e) { const float a_ = y0_[e], b_ = x_[0][4 + e]; x_[0][4 + e] = b_ * cs_[0][e] + a_ * sn_[0][e]; }                       \
      } \
      for (int d0 = 0; d0 < 6; ++d0) qr[d0] = pack8((f32x4){x_[d0][0], x_[d0][1], x_[d0][2], x_[d0][3]}, (f32x4){x_[d0][4], x_[d0][5], x_[d0][6], x_[d0][7]}); } \
    { const bf16_t* gp = pbuf + (rowbase + tpos) * N_INP + N_GL + (4 * g + (r32 & 3)) * 3; \
        for (int i = 0; i < 3; ++i) gate[i] = 1.f / (1.f + __expf(-bf2f(gp[i]))); } \
    } while (0)
    const LAS unsigned char* kbase = lds + L_K + r32 * KP + hi * 16;
    const int vb0 = (int)(uintptr_t)(lds + L_V) + v_rd_base(lane);
    float m_reg, l_reg; int lo_lim, hi_lim;
    f32x16 acc[2] = {};
#define TILE64(NB, BUF, kb0, O, WACT, SELOK) do { const int kb0_ = (kb0); \
        if ((WACT) && __any(hi_lim >= kb0_ && lo_lim <= kb0_ + 63)) { \
            const float c0_ = m_reg > -1e29f ? m_reg : 0.f; const float pi_ = (SELOK) ? -c0_ : -__builtin_inff(); f32x16 p0, p1; \
            _Pragma("unroll") for (int r = 0; r < 16; ++r) { p0[r] = pi_; p1[r] = pi_; } \
            { bf16x8 kf_[12]; \
              _Pragma("unroll") for (int d0 = 0; d0 < 6; ++d0) { kf_[2 * d0] = *(const LAS bf16x8*)(kbase + (BUF) * KT + d0 * 32); kf_[2 * d0 + 1] = *(const LAS bf16x8*)(kbase + (BUF) * KT + 32 * KP + d0 * 32); } \
              SBAR(); \
              _Pragma("unroll") for (int d0 = 0; d0 < 6; ++d0) { p0 = __builtin_amdgcn_mfma_f32_32x32x16_bf16(kf_[2 * d0], qr[d0], p0, 0, 0, 0); p1 = __builtin_amdgcn_mfma_f32_32x32x16_bf16(kf_[2 * d0 + 1], qr[d0], p1, 0, 0, 0); } } \
            if (__any(kb0_ + 63 > hi_lim || kb0_ < lo_lim)) { const float NEG = -__builtin_inff(); \
                _Pragma("unroll") for (int r = 0; r < 16; ++r) { const int kk_ = kb0_ + crow(r, hi); if (kk_ > hi_lim || kk_ < lo_lim) p0[r] = NEG; if (kk_ + 32 > hi_lim || kk_ + 32 < lo_lim) p1[r] = NEG; } } \
            VFrag<NB> va, vb; v_issue<NB, (BUF) * VT>(va, vb0); if (NB == 2) v_issue<NB, (BUF) * VT + 2 * NB * 1024>(vb, vb0); \
            float alpha; bool resc; bf16x8 pa0, pa1, pa2, pa3; \
            softmax64_off(p0, p1, c0_, m_reg, l_reg, alpha, resc, pa0, pa1, pa2, pa3); \
            if (resc) { _Pragma("unroll") for (int r = 0; r < 16; ++r) { _Pragma("unroll") for (int d_ = 0; d_ < NB; ++d_) O[d_][r] *= alpha; } }     \
            v_consume<NB, true>(O, va, pa0, pa1); \
            if (NB != 2) v_issue<NB, (BUF) * VT + 2 * NB * 1024>(vb, vb0); \
            v_consume<NB, true>(O, vb, pa2, pa3); \
        } } while (0)
    {
        const bf16_t* kc = F.kcmp() + ((size_t)b * 4 + g) * 256 * 96; const bf16_t* vc = F.vcmp() + ((size_t)b * 4 + g) * 256 * 64;
        f32x16 o[4] = {}; m_reg = -1e30f; l_reg = 0.f;
        hi_lim = (tpos - 31) >> 4; lo_lim = -(1 << 30);
        const int ntc = (NSA_VAR == 10 || NSA_VAR == 13) ? 0 : (4 * c + 3) / 64 + 1;
#define STAGE_C(t, buf) do { STAGE_K(buf, kc, 192, (t) * 64); \
        GLDS((const unsigned char*)vc + (size_t)((t) * 64 + vk4) * 128 + vc4 * 2, lds + L_V + (buf) * VT + (2 * wid) * 1024); \
        { const int n_ = (t) * 64 + vk4; const int j0_ = vc4; unsigned w_[4]; \
          _Pragma("unroll") for (int e = 0; e < 4; ++e) { const int ja = j0_ + 2 * e, jb = ja + 1; \
              w_[e] = ((n_ >= 4 * ja - 1 && n_ <= 4 * ja + 3) ? 0x3f80u : 0u) | ((n_ >= 4 * jb - 1 && n_ <= 4 * jb + 3) ? 0x3f800000u : 0u); } \
          *(LAS u32x4*)(lds + L_V + (buf) * VT + (2 * wid + 1) * 1024 + lane * 16) = (u32x4){w_[0], w_[1], w_[2], w_[3]}; } } while (0)
        if (ntc) STAGE_C(0, 0);
        if (tid < 2) ((LAS unsigned*)(lds + L_UNI))[tid] = 0u;
        Q_AND_GATES();
        __syncthreads();
        for (int t = 0; t < ntc; t += 2) {
            if (t + 1 < ntc) STAGE_C(t + 1, 1);
            TILE64(4, 0, t * 64, o, true, true);
            __syncthreads();
            if (t + 1 < ntc) {
                if (t + 2 < ntc) STAGE_C(t + 2, 0);
                TILE64(4, 1, (t + 1) * 64, o, true, true);
                __syncthreads();
            }
        }
#undef STAGE_C
        {
            const float rl = l_reg > 0.f ? 1.f / l_reg : 0.f, gr = gate[0] * rl;
            LAS float* imp = (LAS float*)(lds + L_IMP) + (8 * wid + (r32 >> 2)) * 64 + 4 * hi;
#pragma unroll
            for (int r = 0; r < 16; ++r) { acc[0][r] = o[0][r] * gr; acc[1][r] = o[1][r] * gr; }
#pragma unroll
            for (int d = 0; d < 2; ++d)
#pragma unroll
                for (int q4 = 0; q4 < 4; ++q4) { f32x4 iv;
#pragma unroll
                    for (int e = 0; e < 4; ++e) { float v = o[2 + d][4 * q4 + e] * rl; v += get_xor1(v); v += get_xor2(v); iv[e] = v; }
                    if ((r32 & 3) == 0) *(LAS f32x4*)(imp + d * 32 + 8 * q4) = iv; }
        }
    }
#define STAGE_SW(j, buf, koffc, voffc) do { STAGE_K(buf, pbuf + rowbase * N_INP + (koffc) + g * 96, N_INP * 2, (j) * 64); \
    GLDS((const unsigned char*)(pbuf + rowbase * N_INP + (voffc) + g * 64) + (size_t)((j) * 64 + vk2) * (N_INP * 2) + vc2 * 2, lds + L_V + (buf) * VT + wid * 1024); } while (0)
    STAGE_SW(0, 0, N_KS, N_VS);
    unsigned long long mysel = 0ull, wsel = 0ull;
    {
        LAS float* imp = (LAS float*)(lds + L_IMP);
        asm volatile("s_waitcnt lgkmcnt(0)" ::: "memory");
        {
            const int tk = lane >> 3, gp = lane & 7;
            unsigned key[8];
            { const LAS float* ip = imp + (8 * wid + tk) * 64 + 8 * gp; const f32x4 v0 = *(const LAS f32x4*)ip, v1 = *(const LAS f32x4*)(ip + 4);
#pragma unroll
              for (int e = 0; e < 8; ++e) { const int j = 8 * gp + e; const float v = e < 4 ? v0[e] : v1[e - 4]; const bool forced = (j == 0) || (j == c) || (j == c - 1);
                  const float me = forced ? 1e4f : ((j <= c) ? v : -1.f); const unsigned ub = __float_as_uint(me); key[e] = (ub & 0x80000000u) ? ~ub : (ub | 0x80000000u); } }
#define GSUM8(x) do { x += __builtin_amdgcn_update_dpp(0, x, 0x141, 0xf, 0xf, false); x += __builtin_amdgcn_update_dpp(0, x, 0xB1, 0xf, 0xf, false); x += __builtin_amdgcn_update_dpp(0, x, 0x4E, 0xf, 0xf, false); } while (0)
#define GOR8(x) do { x |= __builtin_amdgcn_update_dpp(0, x, 0x141, 0xf, 0xf, false); x |= __builtin_amdgcn_update_dpp(0, x, 0xB1, 0xf, 0xf, false); x |= __builtin_amdgcn_update_dpp(0, x, 0x4E, 0xf, 0xf, false); } while (0)
            unsigned prefix = 0u;
            for (int bit = 31; bit >= 0; --bit) {
                const unsigned cand = prefix | (1u << bit); int cnt = 0;
#pragma unroll
                for (int e = 0; e < 8; ++e) cnt += (key[e] >= cand) ? 1 : 0;
                GSUM8(cnt);
                if (cnt >= 16) prefix = cand;
            }
            int gtc = 0, eqc = 0;
#pragma unroll
            for (int e = 0; e < 8; ++e) { gtc += (key[e] > prefix) ? 1 : 0; eqc += (key[e] == prefix) ? 1 : 0; }
            int gts = gtc; GSUM8(gts); const int need = 16 - gts;
            int run = eqc;
            { int t_ = __builtin_amdgcn_update_dpp(0, run, 0x111, 0xf, 0xf, true); if (gp >= 1) run += t_; t_ = __builtin_amdgcn_update_dpp(0, run, 0x112, 0xf, 0xf, true); if (gp >= 2) run += t_;
              t_ = __builtin_amdgcn_update_dpp(0, run, 0x114, 0xf, 0xf, true); if (gp >= 4) run += t_; }
            run -= eqc;
            unsigned m8 = 0u;
#pragma unroll
            for (int e = 0; e < 8; ++e) { const bool eq_ = key[e] == prefix; if (key[e] > prefix || (eq_ && run < need)) m8 |= 1u << e; if (eq_) ++run; }
            unsigned mlo = gp < 4 ? (m8 << (8 * gp)) : 0u, mhi = gp >= 4 ? (m8 << (8 * (gp - 4))) : 0u;
            GOR8(mlo); GOR8(mhi);
            LAS unsigned* sm = (LAS unsigned*)(lds + L_SELM) + wid * 16;
            if (gp == 0) { sm[2 * tk] = mlo; sm[2 * tk + 1] = mhi; }
            asm volatile("s_waitcnt lgkmcnt(0)" ::: "memory");
            { const int mt = r32 >> 2; mysel = ((unsigned long long)sm[2 * mt + 1] << 32) | sm[2 * mt];
              unsigned wl = 0u, wh = 0u;
#pragma unroll
              for (int t8 = 0; t8 < 8; ++t8) { wl |= sm[2 * t8]; wh |= sm[2 * t8 + 1]; }
              wsel = ((unsigned long long)wh << 32) | wl; }
#undef GSUM8
#undef GOR8
        }
        LAS unsigned* uni = (LAS unsigned*)(lds + L_UNI);
        if (lane == 0) { __hip_atomic_fetch_or(uni, (unsigned)wsel, __ATOMIC_RELAXED, __HIP_MEMORY_SCOPE_WORKGROUP); __hip_atomic_fetch_or(uni + 1, (unsigned)(wsel >> 32), __ATOMIC_RELAXED, __HIP_MEMORY_SCOPE_WORKGROUP); }
        __syncthreads();
    }
    bf16_t* zrow = pbuf + (rowbase + tpos) * N_INP + N_Z + (4 * g + (r32 & 3)) * 64 + 8 * hi;
    u32x4 zz[2][2];
    {
        const LAS unsigned* uni = (const LAS unsigned*)(lds + L_UNI);
        const unsigned long long usel = ((unsigned long long)uni[1] << 32) | uni[0];
        const unsigned long long call = (c == 63) ? ~0ull : ((1ull << (c + 1)) - 1ull);
        for (int br = 0; br < 2; ++br) {
            if (br == 1) {
#pragma unroll
                for (int d0 = 0; d0 < 2; ++d0)
#pragma unroll
                    for (int gp = 0; gp < 2; ++gp) zz[d0][gp] = *(const u32x4*)(zrow + d0 * 32 + gp * 16); }
            unsigned long long tm = br == 0 ? (usel & call) : (call & ~((c >= 9) ? ((1ull << (c - 8)) - 1ull) : 0ull));
            const int koffc = br == 0 ? N_KS : N_KW, voffc = br == 0 ? N_VS : N_VW;
            f32x16 o[2] = {}; m_reg = -1e30f; l_reg = 0.f;
            bool wact, selok; hi_lim = tpos; lo_lim = br == 0 ? -(1 << 30) : tpos - 511;
#define SETLIM() do { selok = br != 0 || ((mysel >> cur) & 1ull); wact = br != 0 || ((wsel >> cur) & 1ull); } while (0)
            int cur = __builtin_ctzll(tm); tm &= tm - 1;
            if (br != 0) STAGE_SW(cur, 0, koffc, voffc);
            __syncthreads();
            for (;;) {
                int nxt = tm ? __builtin_ctzll(tm) : -1; tm &= tm - 1;
                if (nxt >= 0) STAGE_SW(nxt, 1, koffc, voffc);
                SETLIM();
                TILE64(2, 0, cur * 64, o, wact, selok);
                __syncthreads();
                cur = nxt; if (cur < 0) break;
                nxt = tm ? __builtin_ctzll(tm) : -1; tm &= tm - 1;
                if (nxt >= 0) STAGE_SW(nxt, 0, koffc, voffc);
                SETLIM();
                TILE64(2, 1, cur * 64, o, wact, selok);
                __syncthreads();
                cur = nxt; if (cur < 0) break;
            }
            { const float gr = (br == 0 ? gate[1] : gate[2]) * (l_reg > 0.f ? 1.f / l_reg : 0.f);
#pragma unroll
              for (int r = 0; r < 16; ++r) { acc[0][r] += o[0][r] * gr; acc[1][r] += o[1][r] * gr; } }
        }
#undef STAGE_SW
    }
    {
#pragma unroll
        for (int d0 = 0; d0 < 2; ++d0)
#pragma unroll
            for (int gp = 0; gp < 2; ++gp) {
                float ov[8], zf[8];
#pragma unroll
                for (int e = 0; e < 4; ++e) { auto rr = __builtin_amdgcn_permlane32_swap(__float_as_uint(acc[d0][8 * gp + e]), __float_as_uint(acc[d0][8 * gp + 4 + e]), false, false);
                    ov[e] = __uint_as_float(rr[0]); ov[4 + e] = __uint_as_float(rr[1]); }
                unpack8(zz[d0][gp], zf);
#pragma unroll
                for (int e = 0; e < 8; ++e) ov[e] = ov[e] * zf[e] / (1.f + __expf(-zf[e]));
                if (!dry) *(bf16x8*)(zrow + d0 * 32 + gp * 16) = pack8((f32x4){ov[0], ov[1], ov[2], ov[3]}, (f32x4){ov[4], ov[5], ov[6], ov[7]});
            }
    }
#undef TILE64
#undef SETLIM
#undef Q_AND_GATES
#undef STAGE_K
#undef GLDS
}

__device__ __forceinline__ void phase_attn(Frame& F, int jl, int dry) {
    const int bx = blockIdx.x, vcu = (bx & 7) * (GRID / 8) + (bx >> 3);
    if (F.wave >= 4) __builtin_amdgcn_s_setprio(1);
    for (int it = 0; it < 2; ++it) {
        const int item = vcu * 2 + it, bg = item >> 5, s = item & 31;
        for (int pass = 0; pass < 2; ++pass) attn_unit(F, jl, bg >> 2, bg & 3, pass ? s : 63 - s, dry);
    }
    __builtin_amdgcn_s_setprio(0);
}
}

__global__ void __launch_bounds__(NWAVES * 64, 2) mk_fwd(Args args) {
    extern __shared__ __attribute__((aligned(16))) unsigned char lds_raw[];
    Frame F;
    F.lds = (LAS unsigned char*)lds_raw;
    F.tid = threadIdx.x; F.lane = F.tid & 63; F.wave = __builtin_amdgcn_readfirstlane(F.tid >> 6); F.G = gridDim.x;
    F.in = args.in; F.out = args.out; F.ws = args.ws;
    volatile LAS unsigned* MISC = (volatile LAS unsigned*)(F.lds + MISC_OFF);
    if (F.tid < 128) ((LAS unsigned*)(F.lds + LDSCTL_OFF))[F.tid] = 0u;
    __syncthreads();
    const int lo = args.ph_lo, hi = args.ph_hi;
    XcdBarrier bar; bar.bar = (unsigned*)(F.ws + WS_CTL) + CW_BAR; bar.x = 0; bar.st = nullptr;
    if (hi - lo > 1) bar = xcd_barrier_post((unsigned*)(F.ws + WS_CTL) + CW_BAR, MISC + 8);
    for (int ph = lo; ph < hi; ++ph) {
        const PhaseDesc pd = decode_phase(ph);
        { int t_ = threadIdx.x; asm volatile("" : "+v"(t_)); F.tid = t_; F.lane = t_ & 63; }
        { GAS unsigned char* w_ = (GAS unsigned char*)args.ws; GAS float* o_ = (GAS float*)args.out; asm volatile("" : "+s"(w_), "+s"(o_)); F.ws = (unsigned char*)w_; F.out = (float*)o_; }
        const int dry = args.dry;
        switch (pd.kind) {
        case K_PROLOGUE: pro::phase_prologue(F); break;
        case K_MLA_G1: case K_MLA_G2: case K_NSA_G1: {
            if (pd.kind == K_MLA_G2) phase_kpes(F, pd.j);
            pg8::Gemm g; pg8::EpiBf16RS E;
            if (pd.kind == K_MLA_G1) { const MlaW w = mla_w(F.ws, pd.j); g = pg8::Gemm{F.xb(), w.win, T, M_INP, 1024, DM}; E = pg8::EpiBf16RS{F.p1(), M_INP, F.ssqx(), 4, 1.f / 1024.f, dry >= 2 ? dry - 1 : 0, F.ssq1(), 1, F.lds + RING_OFF, nullptr, 0}; }
            else if (pd.kind == K_NSA_G1) { const NsaW w = nsa_w(F.ws, pd.j); g = pg8::Gemm{F.xb(), w.win, T, N_INP, 1024, DM}; E = pg8::EpiBf16RS{F.p1(), N_INP, F.ssqx(), 4, 1.f / 1024.f, dry >= 2 ? dry - 1 : 0, nullptr, 0, F.lds + RING_OFF, nullptr, 0}; }
            else { const MlaW w = mla_w(F.ws, pd.j); g = pg8::Gemm{F.p1() + M_CKV, w.wukv, T, 4096, 256, M_INP};
                   E = pg8::EpiBf16RS{F.kvh(), 2048, F.ssq1() + (size_t)12 * T, 8, 1.f / 256.f, dry >= 2 ? dry - 1 : 0, F.ssqkn(), 2, F.lds + RING_OFF, F.kvh2(), 8}; }
            pg8::OrderRS S; S.init(g.M, g.N, F.G, (int)blockIdx.x); S.rs_ssq = E.rs_ssq; S.rs_nslot = E.rs_nslot; S.lds = F.lds + RING_OFF;
            pg8::gemm_phase<pg8::EpiBf16RS, pg8::OrderRS, true, true>(F.lds + RING_OFF, g, S, E);
        } break;
        case K_OUT: {
            pg8::Gemm g;
            if ((pd.L & 1) == 0) { const MlaW w = mla_w(F.ws, pd.j); g = pg8::Gemm{F.p1() + M_Z, w.wout, T, DM, 2048, M_INP}; }
            else { const NsaW w = nsa_w(F.ws, pd.j); g = pg8::Gemm{F.p1() + N_Z, w.wout, T, DM, 1024, N_INP}; }
            pg8::EpiResid E{pd.L == 0 ? F.f(I_X) : nullptr, F.xb(), pd.L == 3 ? F.out : nullptr, F.ssqx(), dry};
            pg8::StaticOrder S; S.init(T, DM, F.G, (int)blockIdx.x);
            pg8::gemm_phase<pg8::EpiResid, pg8::StaticOrder, false, true>(F.lds + RING_OFF, g, S, E);
        } break;
        case K_MLA_ATT: mla::phase_attn(F, pd.j, dry); break;
        case K_NSA_POST: nsap::phase_post(F, pd.j, dry); break;
        case K_NSA_ATT: nsa::phase_attn(F, pd.j, dry); break;
        default: break;
        }
        if (ph + 1 < hi) xcd_barrier(bar);
    }
}
extern "C" void kernel_launch(void* const* d_in, const int* in_sizes, int n_in, void* d_out, int out_size, void* d_ws, size_t ws_size, hipStream_t stream) {
    if (n_in != N_INPUTS || in_sizes[I_X] != T * DM || out_size != T * DM || ws_size < 256 * MiB) { fprintf(stderr, "kernel_launch: unexpected shapes (n_in %d, out %d, ws %zu); nothing launched\n", n_in, out_size, ws_size); return; }
    static bool attr_done = false;
    if (!attr_done) { attr_done = true;
        if (hipFuncSetAttribute((const void*)mk_fwd, hipFuncAttributeMaxDynamicSharedMemorySize, LDS_BYTES) != hipSuccess) fprintf(stderr, "kernel_launch: hipFuncSetAttribute(%d B LDS) failed\n", LDS_BYTES); }
    (void)hipMemsetAsync((char*)d_ws + WS_CTL, 0, 32768, stream);
    Args a{};
    for (int i = 0; i < N_INPUTS; ++i) a.in[i] = d_in[i];
    a.out = (float*)d_out; a.ws = (unsigned char*)d_ws; a.ph_lo = 0; a.ph_hi = N_PHASES; a.dry = 0; a.pad = 0;
    hipLaunchKernelGGL(mk_fwd, dim3(GRID), dim3(NWAVES * 64), LDS_BYTES, stream, a);
    const hipError_t le = hipPeekAtLastError();
    if (le != hipSuccess) fprintf(stderr, "kernel_launch: launch failed: %s\n", hipGetErrorName(le));
}
```
